# Optimizing an MI355X kernel written in HIP

```python
import jax, jax.numpy as jnp
from jax import lax
import numpy as np

D_MODEL = 4096
BATCH = 8
SEQ = 2048
DEPTH = 1

D_MIX = D_MODEL
HG_WIDTH = D_MIX // 2
HG_HEAD_DIM = 128
HG_HEADS = HG_WIDTH // HG_HEAD_DIM
HG_CHUNK = 64
LRU_WIDTH = D_MIX - HG_WIDTH
LRU_BLOCKS = 16
LRU_BLOCK_DIM = LRU_WIDTH // LRU_BLOCKS
LRU_CONV = 4
LRU_C = 8.0
D_FF = 256 * ((8 * D_MODEL // 3 + 255) // 256)
FFN_CONV = 3
EPS = 1e-6
IN_WIDTHS = (HG_WIDTH, HG_WIDTH, HG_WIDTH, HG_WIDTH, LRU_WIDTH, LRU_WIDTH)
IN_TOTAL = sum(IN_WIDTHS)
IN_SPLIT = tuple(int(v) for v in np.cumsum(IN_WIDTHS)[:-1])

kernel_name = 'hymba_hgrn2_rglru_convffn_block'


def rmsnorm(x, w):
    x32 = x.astype(jnp.float32)
    y = x32 * lax.rsqrt(jnp.mean(x32 * x32, axis=-1, keepdims=True) + EPS)
    return (y * w.astype(jnp.float32)).astype(x.dtype)


def causal_dwconv(x, w, b):
    width = w.shape[0]
    seq = x.shape[1]
    xp = jnp.pad(x, ((0, 0), (width - 1, 0), (0, 0)))
    y = b + xp[:, 0:seq, :] * w[0]
    for j in range(1, width):
        y = y + xp[:, j:j + seq, :] * w[j]
    return y


def hgrn2_chunk_scan(q, k, v, g):
    bsz, seq, nh, dk = q.shape
    dv = v.shape[-1]
    n = seq // HG_CHUNK

    def to_chunks(t):
        return t.reshape(bsz, n, HG_CHUNK, nh, t.shape[-1]).transpose(1, 0, 3, 2, 4)

    causal = jnp.tril(jnp.ones((HG_CHUNK, HG_CHUNK), dtype=bool))[:, :, None]

    def step(state, inp):
        qc, kc, vc, gc = inp
        b = jnp.cumsum(gc, axis=2)
        o_inter = jnp.einsum('bhtk,bhkv->bhtv', qc * jnp.exp(b), state)
        diff = b[:, :, :, None, :] - b[:, :, None, :, :]
        decay = jnp.exp(jnp.where(causal, diff, -jnp.inf))
        scores = jnp.einsum('bhtk,bhtsk,bhsk->bhts', qc, decay, kc)
        o = o_inter + jnp.einsum('bhts,bhsv->bhtv', scores, vc)
        b_last = b[:, :, -1:, :]
        state = (jnp.exp(b_last[:, :, 0, :])[..., None] * state
                 + jnp.einsum('bhsk,bhsv->bhkv', kc * jnp.exp(b_last - b), vc))
        return state, o

    init = jnp.zeros((bsz, nh, dk, dv), jnp.float32)
    _, o = lax.scan(step, init, (to_chunks(q), to_chunks(k), to_chunks(v), to_chunks(g)))
    return o.transpose(1, 0, 3, 2, 4).reshape(bsz, seq, nh, dv)


def hgrn2_group(q_raw, f_raw, i_raw, g_raw, lb, norm_w):
    bsz, seq, _ = q_raw.shape
    q = jax.nn.silu(q_raw.astype(jnp.float32))
    f = lb + (1.0 - lb) * jax.nn.sigmoid(f_raw.astype(jnp.float32))
    k = 1.0 - f
    logf = jnp.log(f)
    v = i_raw.astype(jnp.float32)
    shp = (bsz, seq, HG_HEADS, HG_HEAD_DIM)
    o = hgrn2_chunk_scan(q.reshape(shp), k.reshape(shp), v.reshape(shp), logf.reshape(shp))
    o = rmsnorm(o, norm_w.reshape(HG_HEADS, HG_HEAD_DIM))
    return o.reshape(bsz, seq, HG_WIDTH) * jax.nn.silu(g_raw.astype(jnp.float32))


def _lin_combine(c1, c2):
    a1, b1 = c1
    a2, b2 = c2
    return a1 * a2, a2 * b1 + b2


def rglru_group(x_raw, y_raw, conv_w, conv_b, wa, ba, wx, bx, lam):
    bsz, seq, _ = x_raw.shape
    xb = causal_dwconv(x_raw, conv_w, conv_b).astype(jnp.float32)
    xblk = xb.reshape(bsz, seq, LRU_BLOCKS, LRU_BLOCK_DIM)
    r = jax.nn.sigmoid(jnp.einsum('bsnd,nde->bsne', xblk, wa).reshape(bsz, seq, LRU_WIDTH) + ba)
    i = jax.nn.sigmoid(jnp.einsum('bsnd,nde->bsne', xblk, wx).reshape(bsz, seq, LRU_WIDTH) + bx)
    log_a = -LRU_C * r * jax.nn.softplus(-lam.astype(jnp.float32))
    a = jnp.exp(log_a)
    mult = jnp.sqrt(-jnp.expm1(2.0 * log_a))
    mult = mult.at[:, 0].set(1.0)
    u = xb * i * mult
    _, h = lax.associative_scan(_lin_combine, (a, u), axis=1)
    return h * jax.nn.gelu(y_raw.astype(jnp.float32))


def setup_inputs(seed: int = 0) -> dict:
    key = jax.random.key(seed)
    ks = jax.random.split(key, 20)
    f32 = jnp.float32
    nrm = lambda k, shp, s: (jax.random.normal(k, shp, f32) * s)
    x = jax.random.normal(ks[0], (BATCH, SEQ, D_MODEL), f32)
    ln1_w = 1.0 + nrm(ks[1], (DEPTH, D_MODEL), 0.02)
    w_in = nrm(ks[2], (DEPTH, D_MODEL, IN_TOTAL), D_MODEL ** -0.5)
    lb_gamma = nrm(ks[3], (DEPTH + 1, HG_WIDTH), 0.5)
    hg_norm_w = 1.0 + nrm(ks[4], (DEPTH, HG_WIDTH), 0.02)
    lru_conv_w = nrm(ks[5], (DEPTH, LRU_CONV, LRU_WIDTH), LRU_CONV ** -0.5)
    lru_conv_b = nrm(ks[6], (DEPTH, LRU_WIDTH), 0.02)
    lru_wa = nrm(ks[7], (DEPTH, LRU_BLOCKS, LRU_BLOCK_DIM, LRU_BLOCK_DIM), LRU_BLOCK_DIM ** -0.5)
    lru_ba = nrm(ks[8], (DEPTH, LRU_WIDTH), 0.1)
    lru_wx = nrm(ks[9], (DEPTH, LRU_BLOCKS, LRU_BLOCK_DIM, LRU_BLOCK_DIM), LRU_BLOCK_DIM ** -0.5)
    lru_bx = nrm(ks[10], (DEPTH, LRU_WIDTH), 0.1)
    a_c = jax.random.uniform(ks[11], (DEPTH, LRU_WIDTH), f32, 0.9, 0.999)
    a0 = a_c ** (1.0 / LRU_C)
    lru_lambda = jnp.log(a0) - jnp.log1p(-a0)
    lru_norm_w = 1.0 + nrm(ks[12], (DEPTH, LRU_WIDTH), 0.02)
    w_out = nrm(ks[13], (DEPTH, D_MIX, D_MODEL), D_MIX ** -0.5)
    ln2_w = 1.0 + nrm(ks[14], (DEPTH, D_MODEL), 0.02)
    ffn_w_up = nrm(ks[15], (DEPTH, D_MODEL, 2 * D_FF), D_MODEL ** -0.5)
    ffn_conv_w = nrm(ks[16], (DEPTH, FFN_CONV, 2 * D_FF), FFN_CONV ** -0.5)
    ffn_conv_b = nrm(ks[17], (DEPTH, 2 * D_FF), 0.02)
    ffn_w_down = nrm(ks[18], (DEPTH, D_FF, D_MODEL), D_FF ** -0.5)
    final_norm_w = 1.0 + nrm(ks[19], (D_MODEL,), 0.02)
    return {'x': x, 'ln1_w': ln1_w, 'w_in': w_in, 'lb_gamma': lb_gamma,
            'hg_norm_w': hg_norm_w, 'lru_conv_w': lru_conv_w, 'lru_conv_b': lru_conv_b,
            'lru_wa': lru_wa, 'lru_ba': lru_ba, 'lru_wx': lru_wx, 'lru_bx': lru_bx,
            'lru_lambda': lru_lambda, 'lru_norm_w': lru_norm_w, 'w_out': w_out,
            'ln2_w': ln2_w, 'ffn_w_up': ffn_w_up, 'ffn_conv_w': ffn_conv_w,
            'ffn_conv_b': ffn_conv_b, 'ffn_w_down': ffn_w_down, 'final_norm_w': final_norm_w}


def reference(x, ln1_w, w_in, lb_gamma, hg_norm_w, lru_conv_w, lru_conv_b, lru_wa, lru_ba,
              lru_wx, lru_bx, lru_lambda, lru_norm_w, w_out, ln2_w, ffn_w_up, ffn_conv_w,
              ffn_conv_b, ffn_w_down, final_norm_w):
    lb_all = jnp.cumsum(jax.nn.softmax(lb_gamma.astype(jnp.float32), axis=0), axis=0)
    h = x
    for l in range(DEPTH):
        hn = rmsnorm(h, ln1_w[l])
        proj = jnp.einsum('bsd,de->bse', hn, w_in[l])
        q_r, f_r, i_r, g_r, x_r, y_r = jnp.split(proj, IN_SPLIT, axis=-1)
        o_hg = hgrn2_group(q_r, f_r, i_r, g_r, lb_all[l], hg_norm_w[l])
        o_lru = rglru_group(x_r, y_r, lru_conv_w[l], lru_conv_b[l], lru_wa[l], lru_ba[l],
                            lru_wx[l], lru_bx[l], lru_lambda[l])
        o_lru = rmsnorm(o_lru, lru_norm_w[l])
        mix = jnp.concatenate([o_hg, o_lru], axis=-1).astype(h.dtype)
        h = h + jnp.einsum('bse,ed->bsd', mix, w_out[l])
        hn = rmsnorm(h, ln2_w[l])
        up = jnp.einsum('bsd,df->bsf', hn, ffn_w_up[l])
        up = causal_dwconv(up, ffn_conv_w[l], ffn_conv_b[l])
        gate, val = jnp.split(up, [D_FF], axis=-1)
        h = h + jnp.einsum('bsf,fd->bsd', jax.nn.silu(gate) * val, ffn_w_down[l])
    return rmsnorm(h, final_norm_w)
```

```cpp
#include <hip/hip_runtime.h>
#include <cstdio>
#include <cstdint>

#ifndef MK_N_LAUNCHES
#define MK_N_LAUNCHES 1
#endif

namespace pg8 {
#define PG8_LAS __attribute__((address_space(3)))
typedef unsigned short bf16_t;
typedef short bf16x8 __attribute__((ext_vector_type(8)));
typedef float f32x4 __attribute__((ext_vector_type(4)));
typedef unsigned u32x4 __attribute__((ext_vector_type(4)));
typedef unsigned u32x2 __attribute__((ext_vector_type(2)));
constexpr int BM = 256, BK = 64, HALF = 128, HTB = HALF * BK * 2, STAGE_BYTES = 8 * HTB, NXCD = 8, WGM = 8;

__host__ __device__ __forceinline__ int lds_byte(int r, int c) { const int st = (r >> 4) * 2 + (c >> 5), rr = r & 15, cc = c & 31, ob = rr * 64 + cc * 2; return st * 1024 + (ob ^ (((ob >> 9) & 1) << 5)); }
__host__ __device__ __forceinline__ void stage_rc(int b, int& R, int& C) { const int st = b / 1024, sb = b % 1024, swz = sb ^ (((sb >> 9) & 1) << 5); R = (st >> 1) * 16 + swz / 64; C = (st & 1) * 32 + (swz % 64) / 2; }
__host__ __device__ __forceinline__ int perm32(int rho) { const int n = rho >> 4, i = rho & 15; return 8 * (i >> 2) + 4 * n + (i & 3); }

struct Unit { int pm, pn; };
struct Gemm { const bf16_t* A; const bf16_t* Bt; int M, N, K; };

struct StaticOrder {
    int nM, nN, nwg, G, c, wgm;
    __host__ __device__ void init(int M, int N, int G_, int c_, int wgm_ = WGM) { nM = M / BM; nN = N / BM; nwg = nM * nN; G = G_; c = c_; wgm = wgm_; }
    __host__ __device__ bool next(int i, Unit& u) const {
        const long L = (long)i * G + c; if (L >= nwg) return false;
        int wgid = (int)L; { const int q = nwg / NXCD, r = nwg % NXCD, xcd = wgid % NXCD, off = wgid / NXCD; wgid = (xcd < r ? xcd * (q + 1) : r * (q + 1) + (xcd - r) * q) + off; }
        const int nig = wgm * nN, gid = wgid / nig, fm = gid * wgm, gsz = (nM - fm) < wgm ? (nM - fm) : wgm;
        u.pm = fm + ((wgid % nig) % gsz); u.pn = (wgid % nig) / gsz; return true;
    }
    __device__ __forceinline__ void a_ready(const Unit&) const {}
    __device__ __forceinline__ void done(const Unit&) const {}
};

__device__ __forceinline__ unsigned cvt_pk_bf16(float lo, float hi) { unsigned r; asm volatile("v_cvt_pk_bf16_f32 %0, %1, %2" : "=v"(r) : "v"(lo), "v"(hi)); return r; }

struct DynTailOrder : StaticOrder {
    unsigned* counter; volatile PG8_LAS unsigned* slot; int nstatic, ntail;
    __device__ __forceinline__ void init2(int M, int N, int G_, int c_, unsigned* counter_, volatile PG8_LAS unsigned* slot_) { init(M, N, G_, c_); counter = counter_; slot = slot_; nstatic = nwg / G; ntail = nwg % G; }
    __device__ __forceinline__ bool next(int i, Unit& u) const {
        if (i < nstatic) return StaticOrder::next(i, u);
        if (i > nstatic || ntail == 0) return false;
        if (threadIdx.x == 0) { const unsigned t = __hip_atomic_fetch_add(counter, 1u, __ATOMIC_RELAXED, __HIP_MEMORY_SCOPE_AGENT); *slot = t; }
        asm volatile("s_waitcnt lgkmcnt(0)" ::: "memory"); __builtin_amdgcn_s_barrier(); asm volatile("" ::: "memory");
        const unsigned t = *slot;
        if (t >= (unsigned)ntail) return false;
        StaticOrder T = *this; T.c = (int)t;
        return T.StaticOrder::next(nstatic, u);
    }
};

template <class Epi, class Sched, bool ALIGN_EPI = false, bool SP2 = false, bool AROWPERM = false, bool MIDSCALE = false>
__device__ __forceinline__ void gemm_phase(PG8_LAS unsigned char* lds, const Gemm g, const Sched& S, const Epi& E, const PG8_LAS float* midtab = nullptr, int midpm0 = 0) {
    const int tid = threadIdx.x, wid = __builtin_amdgcn_readfirstlane(tid >> 6), lane = tid & 63, wr = wid >> 2, wc = wid & 3, fr = lane & 15, fq = lane >> 4;
    const int K = g.K, nt = K / BK;
    unsigned voffA[2], voffB[2];
#pragma unroll
    for (int i = 0; i < 2; ++i) { int R, C; stage_rc(tid * 16 + i * 8192, R, C); const int Rb = Epi::PERM ? ((R & ~31) + perm32(R & 31)) : R;
        const int Ra = AROWPERM ? (128 * (R >> 6) + (R & 63)) : R;
        voffA[i] = (unsigned)(Ra * K + C) * 2u; voffB[i] = (unsigned)(Rb * K + C) * 2u; }
    const size_t kstep = (size_t)(BK * 2);
    const size_t hstepB = (size_t)HALF * K * 2;
    const size_t hstepA = AROWPERM ? (size_t)64 * K * 2 : (size_t)HALF * K * 2;
    const size_t tstep = (size_t)BM * K * 2;
    const unsigned ldsw = (unsigned)wid * 1024u;
    const int aoff = lds_byte(wr * 64 + fr, fq * 8), boff = lds_byte(wc * 32 + fr, fq * 8);
#define PG8_SA(b, h) (((b) * 2 + (h)) * HTB)
#define PG8_SB(b, h) ((4 + (b) * 2 + (h)) * HTB)
#define PG8_STAGE(bufoff, gbase, voff) do { _Pragma("unroll") for (int _i = 0; _i < 2; ++_i) \
        __builtin_amdgcn_global_load_lds((const unsigned*)((const char*)(gbase) + (voff)[_i]), (PG8_LAS unsigned*)(lds + (bufoff) + ldsw + _i * 8192), 16, 0, 0); } while (0)
#define PG8_LDA(dst, b, h) do { _Pragma("unroll") for (int m = 0; m < 4; ++m) _Pragma("unroll") for (int k = 0; k < 2; ++k) dst[m][k] = *(const PG8_LAS bf16x8*)(lds + PG8_SA(b, h) + aoff + m * 2048 + k * 1024); } while (0)
#define PG8_LDB(dst, b, h) do { _Pragma("unroll") for (int n = 0; n < 2; ++n) _Pragma("unroll") for (int k = 0; k < 2; ++k) dst[n][k] = *(const PG8_LAS bf16x8*)(lds + PG8_SB(b, h) + boff + n * 2048 + k * 1024); } while (0)
#define PG8_MMA(ai, bj, At, Bt) do { __builtin_amdgcn_s_setprio(1); _Pragma("unroll") for (int m = 0; m < 4; ++m) _Pragma("unroll") for (int n = 0; n < 2; ++n) _Pragma("unroll") for (int k = 0; k < 2; ++k) \
        acc[ai][bj][m][n] = __builtin_amdgcn_mfma_f32_16x16x32_bf16(Bt[n][k], At[m][k], acc[ai][bj][m][n], 0, 0, 0); __builtin_amdgcn_s_setprio(0); } while (0)
#define PG8_WAIT_V(n) asm volatile("s_waitcnt vmcnt(" #n ")" ::: "memory")
#define PG8_WAIT_L(n) asm volatile("s_waitcnt lgkmcnt(" #n ")" ::: "memory")
#define PG8_BAR __builtin_amdgcn_s_barrier()
#define PG8_SCHED __builtin_amdgcn_sched_barrier(0)
    Unit cur, nxt; int ui = 0;
    if (!S.next(0, cur)) return;
    f32x4 acc[2][2][4][2];
#pragma unroll
    for (int a = 0; a < 2; ++a)
#pragma unroll
        for (int b = 0; b < 2; ++b)
#pragma unroll
            for (int m = 0; m < 4; ++m)
#pragma unroll
                for (int n = 0; n < 2; ++n) acc[a][b][m][n] = (f32x4){0.f, 0.f, 0.f, 0.f};
    bf16x8 At[4][2], B0[2][2], B1[2][2];
    const char* cA = (const char*)g.A + (size_t)cur.pm * tstep; const char* cB = (const char*)g.Bt + (size_t)cur.pn * tstep;
    S.a_ready(cur);
    if constexpr (SP2) {
        PG8_STAGE(PG8_SB(0, 0), cB, voffB); PG8_STAGE(PG8_SB(0, 1), cB + hstepB, voffB); PG8_STAGE(PG8_SA(0, 0), cA, voffA); PG8_STAGE(PG8_SA(0, 1), cA + hstepA, voffA);
        if (wr == 1) PG8_BAR;
        PG8_WAIT_V(2); PG8_BAR;
        PG8_STAGE(PG8_SB(1, 0), cB + kstep, voffB); PG8_STAGE(PG8_SA(1, 0), cA + kstep, voffA); PG8_STAGE(PG8_SB(1, 1), cB + hstepB + kstep, voffB);
        PG8_WAIT_V(6); PG8_BAR;
    } else {
        PG8_STAGE(PG8_SB(0, 0), cB, voffB); PG8_STAGE(PG8_SA(0, 0), cA, voffA); PG8_STAGE(PG8_SB(0, 1), cB + hstepB, voffB); PG8_STAGE(PG8_SA(0, 1), cA + hstepA, voffA);
        if (wr == 1) PG8_BAR;
        PG8_WAIT_V(4); PG8_BAR;
        PG8_STAGE(PG8_SB(1, 0), cB + kstep, voffB); PG8_STAGE(PG8_SA(1, 0), cA + kstep, voffA); PG8_STAGE(PG8_SB(1, 1), cB + hstepB + kstep, voffB);
        PG8_WAIT_V(6); PG8_BAR;
    }
    for (;;) {
        const bool has_next = S.next(ui + 1, nxt);
        const char* nA = has_next ? (const char*)g.A + (size_t)nxt.pm * tstep : cA; const char* nB = has_next ? (const char*)g.Bt + (size_t)nxt.pn * tstep : cB;
        for (int t = 0; t < nt; t += 2) {
            const bool last = (t == nt - 2);
            const char* a1 = cA + (size_t)(t + 1) * kstep;
            const char* a2 = last ? nA : cA + (size_t)(t + 2) * kstep; const char* b2 = last ? nB : cB + (size_t)(t + 2) * kstep;
            const char* a3 = a2 + kstep; const char* b3 = b2 + kstep;
            if (last && has_next) S.a_ready(nxt);
            if constexpr (MIDSCALE) { if (t == nt / 2) {
#pragma unroll
                for (int a = 0; a < 2; ++a)
#pragma unroll
                    for (int m = 0; m < 4; ++m) { const float sc = midtab[(cur.pm - midpm0) * 256 + a * 128 + wr * 64 + m * 16 + fr];
#pragma unroll
                        for (int b = 0; b < 2; ++b)
#pragma unroll
                            for (int n = 0; n < 2; ++n) acc[a][b][m][n] = acc[a][b][m][n] * sc; } } }
            if constexpr (SP2) {
            PG8_LDB(B0, 0, 0); PG8_LDB(B1, 0, 1); PG8_SCHED; PG8_LDA(At, 0, 0); PG8_STAGE(PG8_SA(1, 1), a1 + hstepA, voffA);
            PG8_WAIT_V(8); PG8_WAIT_L(0); PG8_BAR; PG8_MMA(0, 0, At, B0); PG8_MMA(0, 1, At, B1); PG8_BAR; PG8_SCHED;
            PG8_LDA(At, 0, 1); PG8_STAGE(PG8_SB(0, 0), b2, voffB); PG8_STAGE(PG8_SB(0, 1), b2 + hstepB, voffB); PG8_STAGE(PG8_SA(0, 0), a2, voffA);
            PG8_WAIT_V(8); PG8_WAIT_L(0); PG8_BAR; PG8_MMA(1, 0, At, B0); PG8_MMA(1, 1, At, B1); PG8_BAR; PG8_SCHED;
            PG8_LDB(B0, 1, 0); PG8_LDB(B1, 1, 1); PG8_SCHED; PG8_LDA(At, 1, 0); PG8_STAGE(PG8_SA(0, 1), a2 + hstepA, voffA);
            PG8_WAIT_V(8); PG8_WAIT_L(0); PG8_BAR; PG8_MMA(0, 0, At, B0); PG8_MMA(0, 1, At, B1); PG8_BAR; PG8_SCHED;
            PG8_LDA(At, 1, 1); PG8_STAGE(PG8_SB(1, 0), b3, voffB); PG8_STAGE(PG8_SB(1, 1), b3 + hstepB, voffB); PG8_STAGE(PG8_SA(1, 0), a3, voffA);
            PG8_WAIT_V(8); PG8_WAIT_L(0); PG8_BAR; PG8_MMA(1, 0, At, B0); PG8_MMA(1, 1, At, B1); PG8_BAR; PG8_SCHED;
            } else {
            PG8_LDB(B0, 0, 0); PG8_SCHED; PG8_LDA(At, 0, 0); PG8_STAGE(PG8_SA(1, 1), a1 + hstepA, voffA);
            PG8_WAIT_L(8); PG8_BAR; PG8_WAIT_L(0); PG8_MMA(0, 0, At, B0); PG8_BAR; PG8_SCHED;
            PG8_LDB(B1, 0, 1); PG8_STAGE(PG8_SB(0, 0), b2, voffB);
            PG8_BAR; PG8_WAIT_L(0); PG8_MMA(0, 1, At, B1); PG8_BAR;
            PG8_LDA(At, 0, 1); PG8_STAGE(PG8_SA(0, 0), a2, voffA);
            PG8_BAR; PG8_WAIT_L(0); PG8_MMA(1, 0, At, B0); PG8_BAR; PG8_SCHED;
            PG8_STAGE(PG8_SB(0, 1), b2 + hstepB, voffB);
            PG8_WAIT_V(6); PG8_BAR; PG8_MMA(1, 1, At, B1); PG8_BAR;
            PG8_LDB(B0, 1, 0); PG8_SCHED; PG8_LDA(At, 1, 0); PG8_STAGE(PG8_SA(0, 1), a2 + hstepA, voffA);
            PG8_WAIT_L(8); PG8_BAR; PG8_WAIT_L(0); PG8_MMA(0, 0, At, B0); PG8_BAR; PG8_SCHED;
            PG8_LDB(B1, 1, 1); PG8_STAGE(PG8_SB(1, 0), b3, voffB);
            PG8_BAR; PG8_WAIT_L(0); PG8_MMA(0, 1, At, B1); PG8_BAR;
            PG8_LDA(At, 1, 1); PG8_STAGE(PG8_SA(1, 0), a3, voffA);
            PG8_BAR; PG8_WAIT_L(0); PG8_MMA(1, 0, At, B0); PG8_BAR; PG8_SCHED;
            PG8_STAGE(PG8_SB(1, 1), b3 + hstepB, voffB);
            PG8_WAIT_V(6); PG8_BAR; PG8_MMA(1, 1, At, B1); PG8_BAR;
            }
        }
        if constexpr (ALIGN_EPI) { if (wr == 0) PG8_BAR; }
        E(acc, cur, wr, wc, fr, fq); S.done(cur);
        if (!has_next) break;
#pragma unroll
        for (int a = 0; a < 2; ++a)
#pragma unroll
            for (int b = 0; b < 2; ++b)
#pragma unroll
                for (int m = 0; m < 4; ++m)
#pragma unroll
                    for (int n = 0; n < 2; ++n) acc[a][b][m][n] = (f32x4){0.f, 0.f, 0.f, 0.f};
        cur = nxt; cA = nA; cB = nB; ++ui;
        if constexpr (ALIGN_EPI) { if (wr == 1) PG8_BAR; }
    }
    PG8_WAIT_V(0);
    if constexpr (!ALIGN_EPI) { if (wr == 0) PG8_BAR; }
    PG8_BAR;
#undef PG8_SA
#undef PG8_SB
#undef PG8_STAGE
#undef PG8_LDA
#undef PG8_LDB
#undef PG8_MMA
#undef PG8_WAIT_V
#undef PG8_WAIT_L
#undef PG8_BAR
#undef PG8_SCHED
}
}

#ifndef PG8_SP2
#define PG8_SP2 true
#endif
#ifndef PG8_ALIGN
#define PG8_ALIGN true
#endif

constexpr int NWAVES = 8;
constexpr int BATCH = 8, SEQ = 2048, D = 4096, M = BATCH * SEQ;
constexpr int HGW = 2048, HD = 128, NH = 16, LRUW = 2048, NLB = 16, LBD = 128;
constexpr int NIN = 12288, DFF = 11008, NUP = 2 * DFF;
constexpr float EPS = 1e-6f;
constexpr int NSTRIP = M / 128;

constexpr size_t MiB = 1u << 20;
constexpr size_t WS_CTL = 0, CTL_ZERO_BYTES = 1 * MiB;
constexpr size_t WS_WIN = 1 * MiB;
constexpr size_t WS_WOUT = WS_WIN + (size_t)NIN * D * 2;
constexpr size_t WS_WUP = WS_WOUT + (size_t)D * D * 2;
constexpr size_t WS_WDN = WS_WUP + (size_t)NUP * D * 2;
constexpr size_t WS_XN = WS_WDN + (size_t)D * DFF * 2;
constexpr size_t WS_PROJ = WS_XN + (size_t)M * D * 2;
constexpr size_t WS_ACT = WS_PROJ;
constexpr size_t WS_MIX = WS_PROJ + (size_t)M * NIN * 2;
constexpr size_t WS_SIDE = WS_MIX + (size_t)M * D * 2;
constexpr size_t WS_SSQL = WS_SIDE + (size_t)NSTRIP * 4 * NUP * 4;
constexpr size_t WS_SSQ2 = WS_SSQL + (size_t)16 * M * 4;
constexpr size_t WS_RSTG = WS_SSQ2 + (size_t)M * 64 * 4;
constexpr size_t WS_END = WS_RSTG + (size_t)M * 4;
constexpr int CW_TMO = 0, CW_CODE = 1, CW_BAR = 4096;

constexpr int RING_OFF = 0, RING_BYTES = 131072;
constexpr int LDSCTL_OFF = 143360, MISC_OFF = LDSCTL_OFF + 320;
constexpr int LDS_BYTES = 147456;

#define GAS __attribute__((address_space(1)))
#define LAS __attribute__((address_space(3)))
typedef unsigned short bf16;
typedef unsigned v4u __attribute__((ext_vector_type(4)));
typedef unsigned v2u __attribute__((ext_vector_type(2)));
typedef float f32x4 __attribute__((ext_vector_type(4)));
typedef float f32x2 __attribute__((ext_vector_type(2)));
typedef GAS unsigned gu32;
#define RLX_AGENT __ATOMIC_RELAXED, __HIP_MEMORY_SCOPE_AGENT
#define LDS_WAIT() asm volatile("s_waitcnt lgkmcnt(0)" ::: "memory")
#define VM_WAIT() asm volatile("s_waitcnt vmcnt(0)" ::: "memory")
__device__ __forceinline__ unsigned f2bf(float f) { unsigned u = __builtin_bit_cast(unsigned, f); return (u + 0x7fffu + ((u >> 16) & 1u)) >> 16; }
__device__ __forceinline__ unsigned pk2(float lo, float hi) { return f2bf(lo) | (f2bf(hi) << 16); }
typedef __bf16 bf16x2_t __attribute__((ext_vector_type(2)));
__device__ __forceinline__ unsigned cvtpk(float lo, float hi) { const f32x2 v = {lo, hi}; const bf16x2_t b = __builtin_convertvector(v, bf16x2_t); return __builtin_bit_cast(unsigned, b); }
__device__ __forceinline__ float bf_lo(unsigned u) { return __builtin_bit_cast(float, u << 16); }
__device__ __forceinline__ float bf_hi(unsigned u) { return __builtin_bit_cast(float, u & 0xffff0000u); }
__device__ __forceinline__ float fexp(float x) { return __builtin_amdgcn_exp2f(x * 1.44269504089f); }
__device__ __forceinline__ float sigmoidf_(float x) { return __builtin_amdgcn_rcpf(1.0f + fexp(-x)); }
__device__ __forceinline__ float siluf_(float x) { return x * sigmoidf_(x); }
__device__ __forceinline__ float gelu_tanh_(float y) { const float z = 0.7978845608028654f * (y + 0.044715f * y * y * y); return y * sigmoidf_(2.0f * z); }

#define XB_TMO      128
#define XB_XCNT(j)  (256  + 64 * (j))
#define XB_XSUB(j)  (1280 + 64 * (j))
#define XB_XGEN(j)  (2304 + 64 * (j))
#define XB_TOP      3328
#define XB_TOPGEN   3392
#define XCD_BAR_WORDS 3456
#define XB_SPIN_CAP (1u << 18)
__device__ __forceinline__ unsigned xb_ld(unsigned* p)              { return __hip_atomic_load(p, __ATOMIC_RELAXED, __HIP_MEMORY_SCOPE_AGENT); }
__device__ __forceinline__ unsigned xb_add(unsigned* p, unsigned v) { return __hip_atomic_fetch_add(p, v, __ATOMIC_RELAXED, __HIP_MEMORY_SCOPE_AGENT); }
__device__ __forceinline__ unsigned xb_xcc_id() { return (unsigned)__builtin_amdgcn_s_getreg((3 << 11) | 20) & 0xFu; }
#define XB_SPIN(cond, bar) do { unsigned _sp = 0; while (cond) { __builtin_amdgcn_s_sleep(1); \
    if ((++_sp & 255u) == 0u) { if (xb_ld(&(bar)[XB_TMO])) break; if (_sp > XB_SPIN_CAP) { atomicAdd(&(bar)[XB_TMO], 1u); break; } } } } while (0)
struct XcdBarrier { unsigned* bar; unsigned x; volatile LAS unsigned* st; };
__device__ __forceinline__ XcdBarrier xcd_barrier_post(unsigned* bar, volatile LAS unsigned* st) {
    XcdBarrier b; b.bar = bar; b.x = xb_xcc_id(); b.st = st;
    if (threadIdx.x == 0) (void)xb_add(&bar[XB_XCNT(b.x)], 1u);
    return b;
}
__device__ __forceinline__ void xcd_barrier_complete(unsigned* bar, unsigned x, unsigned& nloc, unsigned& nx) {
    const unsigned G = gridDim.x * gridDim.y * gridDim.z;
    unsigned sum, cnt, mine, sp = 0u;
    for (;;) {
        sum = 0u; cnt = 0u; mine = 0u;
#pragma unroll
        for (unsigned j = 0; j < 16; ++j) { const unsigned c = xb_ld(&bar[XB_XCNT(j)]); sum += c; cnt += (c > 0u) ? 1u : 0u; mine = (j == x) ? c : mine; }
        if (sum == G) break;
        __builtin_amdgcn_s_sleep(1);
        if ((++sp & 255u) == 0u) { if (xb_ld(&bar[XB_TMO])) break; if (sp > XB_SPIN_CAP) { atomicAdd(&bar[XB_TMO], 1u); break; } }
    }
    nloc = mine > 0u ? mine : 1u; nx = cnt > 0u ? cnt : 1u;
}
__device__ __forceinline__ void xcd_barrier(const XcdBarrier& b) {
    asm volatile("s_waitcnt vmcnt(0)" ::: "memory");
    __syncthreads();
    if (threadIdx.x == 0) {
        unsigned* bar = b.bar;
        __builtin_amdgcn_s_waitcnt(0);
        unsigned nloc = b.st[0], nx = b.st[1];
        if (nloc == 0u) { xcd_barrier_complete(bar, b.x, nloc, nx); b.st[0] = nloc; b.st[1] = nx; }
        const unsigned old = xb_add(&bar[XB_XSUB(b.x)], 1u);
        const unsigned gen = old / nloc;
        if (old + 1u == (gen + 1u) * nloc) {
            __builtin_amdgcn_fence(__ATOMIC_RELEASE, "agent");
            asm volatile("s_waitcnt vmcnt(0)" ::: "memory");
            const unsigned og = xb_add(&bar[XB_TOP], 1u);
            const unsigned tg = og / nx;
            if (og + 1u == (tg + 1u) * nx) xb_add(&bar[XB_TOPGEN], 1u);
            else XB_SPIN(xb_ld(&bar[XB_TOPGEN]) == tg, bar);
            __builtin_amdgcn_fence(__ATOMIC_ACQUIRE, "agent");
            xb_add(&bar[XB_XGEN(b.x)], 1u);
            asm volatile("s_waitcnt vmcnt(0)" ::: "memory");
        } else {
            XB_SPIN(xb_ld(&bar[XB_XGEN(b.x)]) == gen, bar);
            __builtin_amdgcn_fence(__ATOMIC_ACQUIRE, "agent");
            asm volatile("s_waitcnt vmcnt(0)" ::: "memory");
        }
    }
    __syncthreads();
}

struct Frame {
    LAS unsigned char* lds;
    volatile LAS unsigned* MISC;
    gu32* ctl;
    int tid, lane, wave;
    int vcu, G;
    const float* x; float* out;
    const float *ln1_w, *w_in, *lb_gamma, *hg_norm_w, *lru_conv_w, *lru_conv_b, *lru_wa, *lru_ba, *lru_wx, *lru_bx, *lru_lambda, *lru_norm_w, *w_out, *ln2_w, *w_up, *ffn_conv_w, *ffn_conv_b, *w_down, *final_norm_w;
    bf16 *Win_t, *Wout_t, *Wup_t, *Wdn_t;
    bf16 *XN, *PROJ, *MIX, *ACT;
    float *SIDE, *SSQL, *SSQ2, *RSTG;
};

__device__ __forceinline__ float wave_sum(float v) {
#pragma unroll
    for (int o = 1; o < 64; o <<= 1) v += __shfl_xor(v, o);
    return v;
}

__device__ __forceinline__ void p0_transpose_item(const float* W, int N, bf16* WT, int ldt, int dst_row, int k0, int n0, LAS float* scr, int lane, const float* kscale = nullptr, int kdst = -1) {
    if (kdst < 0) kdst = k0;
#pragma unroll 8
    for (int i = 0; i < 32; ++i) { const int kk = 2 * i + (lane >> 5); scr[kk * 33 + (lane & 31)] = __builtin_nontemporal_load(&W[(size_t)(k0 + kk) * N + n0 + (lane & 31)]); }
    LDS_WAIT(); asm volatile("" ::: "memory");
    const int c = lane & 7;
    f32x4 sc0 = (f32x4){1.f, 1.f, 1.f, 1.f}, sc1 = sc0;
    if (kscale) { sc0 = *(const GAS f32x4*)(kscale + k0 + 8 * c); sc1 = *(const GAS f32x4*)(kscale + k0 + 8 * c + 4); }
#pragma unroll
    for (int j = 0; j < 4; ++j) { const int n = (lane >> 3) + 8 * j; const LAS float* s = scr + (8 * c) * 33 + n;
        v4u o; o.x = cvtpk(s[0 * 33] * sc0.x, s[1 * 33] * sc0.y); o.y = cvtpk(s[2 * 33] * sc0.z, s[3 * 33] * sc0.w); o.z = cvtpk(s[4 * 33] * sc1.x, s[5 * 33] * sc1.y); o.w = cvtpk(s[6 * 33] * sc1.z, s[7 * 33] * sc1.w);
        *(GAS v4u*)(WT + (size_t)(dst_row + n) * ldt + kdst + 8 * c) = o; }
    LDS_WAIT(); asm volatile("" ::: "memory");
}
__device__ __forceinline__ void rms_row_to_bf16(int lane, const float* xrow, const float* w, bf16* orow) {
    const GAS f32x4* xr = (const GAS f32x4*)xrow + lane;
    f32x4 v[16]; float s = 0.f;
#pragma unroll
    for (int j = 0; j < 16; ++j) { v[j] = __builtin_nontemporal_load(&xr[64 * j]); s += (v[j].x * v[j].x + v[j].y * v[j].y) + (v[j].z * v[j].z + v[j].w * v[j].w); }
    const float rstd = __builtin_amdgcn_rsqf(wave_sum(s) * (1.f / D) + EPS);
    GAS unsigned long long* o8 = (GAS unsigned long long*)orow + lane;
    const GAS f32x4* wr = (const GAS f32x4*)w + lane;
#pragma unroll
    for (int j = 0; j < 16; ++j) { const f32x4 g = wr[64 * j]; o8[64 * j] = (unsigned long long)pk2(v[j].x * rstd * g.x, v[j].y * rstd * g.y) | ((unsigned long long)pk2(v[j].z * rstd * g.z, v[j].w * rstd * g.w) << 32); }
}
__device__ __forceinline__ void rms_row_bf16_to_f32(int lane, const bf16* hrow, const float* w, float* orow) {
    const GAS v2u* hr = (const GAS v2u*)hrow + lane;
    v2u v[16]; float s = 0.f;
#pragma unroll
    for (int j = 0; j < 16; ++j) { v[j] = hr[64 * j]; const float a0 = bf_lo(v[j].x), a1 = bf_hi(v[j].x), a2 = bf_lo(v[j].y), a3 = bf_hi(v[j].y); s += (a0 * a0 + a1 * a1) + (a2 * a2 + a3 * a3); }
    const float rstd = __builtin_amdgcn_rsqf(wave_sum(s) * (1.f / D) + EPS);
    GAS f32x4* o = (GAS f32x4*)orow + lane;
    const GAS f32x4* wr = (const GAS f32x4*)w + lane;
#pragma unroll
    for (int j = 0; j < 16; ++j) { const f32x4 g = wr[64 * j]; __builtin_nontemporal_store((f32x4){bf_lo(v[j].x) * rstd * g.x, bf_hi(v[j].x) * rstd * g.y, bf_lo(v[j].y) * rstd * g.z, bf_hi(v[j].y) * rstd * g.w}, &o[64 * j]); }
}
template <int WHICH> __device__ __forceinline__ void p_convert_w(Frame& F) {
    LAS float* scr = (LAS float*)(F.lds + RING_OFF + F.wave * 16384);
    const int gw = F.vcu * NWAVES + F.wave, NGW = F.G * NWAVES;
    constexpr int I_IN = (D / 64) * (NIN / 32), I_OUT = (D / 64) * (D / 32), I_UP = (D / 64) * (NUP / 32);
    constexpr int NITEMS = WHICH == 0 ? I_IN : WHICH == 1 ? I_OUT : I_UP;
    for (int r = gw; r < NITEMS; r += NGW) {
        if constexpr (WHICH == 0) { const int nblk = NIN / 32, kb = r / nblk, nb = r % nblk; p0_transpose_item(F.w_in, NIN, F.Win_t, D, 32 * nb, 64 * kb, 32 * nb, scr, F.lane); }
        else if constexpr (WHICH == 1) { const int nblk = D / 32, kb = r / nblk, nb = r % nblk; const int k0 = 64 * kb;
            p0_transpose_item(F.w_out, D, F.Wout_t, D, 32 * nb, k0, 32 * nb, scr, F.lane, k0 >= HGW ? F.lru_norm_w - HGW : nullptr, k0 ^ HGW); }
        else { const int nblk = NUP / 32, kb = r / nblk, nb = r % nblk; int n0 = 32 * nb; const int isval = n0 >= DFF ? 1 : 0; const int c = n0 - isval * DFF;
            const int drow = 256 * (c >> 7) + 128 * isval + (c & 127);
            p0_transpose_item(F.w_up, NUP, F.Wup_t, D, drow, 64 * kb, n0, scr, F.lane, F.ln2_w); }
    }
}
__device__ __forceinline__ void p0_prologue(Frame& F) {
    const int gw = F.vcu * NWAVES + F.wave, NGW = F.G * NWAVES;
    p_convert_w<0>(F);
    for (int m = gw; m < M; m += NGW) rms_row_to_bf16(F.lane, F.x + (size_t)m * D, F.ln1_w, F.XN + (size_t)m * D);
}
__device__ __forceinline__ void p_convert_wdown(Frame& F, int rank, int nw) {
    LAS float* scr = (LAS float*)(F.lds + RING_OFF + F.wave * 16384);
    constexpr int I_DN = (DFF / 64) * (D / 32);
    for (int it = rank * NWAVES + F.wave; it < I_DN; it += nw * NWAVES) { const int nblk = D / 32, kb = it / nblk, nb = it % nblk;
        p0_transpose_item(F.w_down, D, F.Wdn_t, DFF, 32 * nb, 64 * kb, 32 * nb, scr, F.lane); }
}
struct EpiProj {
    static constexpr bool PERM = true;
    bf16* O; const float* lb_gamma;
    __device__ __forceinline__ void operator()(const pg8::f32x4 (&acc)[2][2][4][2], const pg8::Unit& u, int wr, int wc, int fr, int fq) const {
        const int row0 = u.pm * 256 + wr * 64 + fr, col0 = u.pn * 256 + wc * 32 + 8 * fq;
        const int grp = u.pn >> 3;
        float oml[2][8];
        if (grp == 1) {
#pragma unroll
            for (int bj = 0; bj < 2; ++bj)
#pragma unroll
                for (int j = 0; j < 8; ++j) { const int c = col0 + bj * 128 + j - HGW; oml[bj][j] = __builtin_amdgcn_rcpf(1.0f + fexp(lb_gamma[c] - lb_gamma[HGW + c])); }
        } else {
#pragma unroll
            for (int bj = 0; bj < 2; ++bj)
#pragma unroll
                for (int j = 0; j < 8; ++j) oml[bj][j] = 0.f;
        }
#pragma unroll
        for (int ai = 0; ai < 2; ++ai)
#pragma unroll
            for (int m = 0; m < 4; ++m) { bf16* rowp = O + (size_t)(row0 + ai * 128 + m * 16) * NIN + col0;
#pragma unroll
                for (int bj = 0; bj < 2; ++bj) { float v[8];
#pragma unroll
                    for (int j = 0; j < 8; ++j) v[j] = acc[ai][bj][m][j >> 2][j & 3];
                    if (grp == 0 || grp == 3) {
#pragma unroll
                        for (int j = 0; j < 8; ++j) v[j] = siluf_(v[j]);
                    } else if (grp == 1) {
#pragma unroll
                        for (int j = 0; j < 8; ++j) v[j] = oml[bj][j] * __builtin_amdgcn_rcpf(1.0f + fexp(v[j]));
                    } else if (grp == 5) {
#pragma unroll
                        for (int j = 0; j < 8; ++j) v[j] = gelu_tanh_(v[j]);
                    }
                    pg8::u32x4 w; w.x = pg8::cvt_pk_bf16(v[0], v[1]); w.y = pg8::cvt_pk_bf16(v[2], v[3]); w.z = pg8::cvt_pk_bf16(v[4], v[5]); w.w = pg8::cvt_pk_bf16(v[6], v[7]);
                    *(pg8::u32x4*)(rowp + bj * 128) = w; } }
    }
};
struct EpiRes2 {
    static constexpr bool PERM = true;
    const float* x; bf16* H; float* ssq;
    __device__ __forceinline__ void operator()(const pg8::f32x4 (&acc)[2][2][4][2], const pg8::Unit& u, int wr, int wc, int fr, int fq) const {
        const int row0 = u.pm * 256 + wr * 64 + fr, col0 = u.pn * 256 + wc * 32 + 8 * fq;
#pragma unroll
        for (int ai = 0; ai < 2; ++ai) {
            pg8::f32x4 r[4][2][2];
#pragma unroll
            for (int m = 0; m < 4; ++m) { const size_t off = (size_t)(row0 + ai * 128 + m * 16) * D + col0;
#pragma unroll
                for (int bj = 0; bj < 2; ++bj) { r[m][bj][0] = *(const pg8::f32x4*)(x + off + bj * 128); r[m][bj][1] = *(const pg8::f32x4*)(x + off + bj * 128 + 4); } }
#pragma unroll
            for (int m = 0; m < 4; ++m) { const int row = row0 + ai * 128 + m * 16; const size_t off = (size_t)row * D + col0; float ss = 0.f;
#pragma unroll
                for (int bj = 0; bj < 2; ++bj) { const pg8::f32x4 v0 = r[m][bj][0] + acc[ai][bj][m][0], v1 = r[m][bj][1] + acc[ai][bj][m][1];
                    ss += ((v0[0] * v0[0] + v0[1] * v0[1]) + (v0[2] * v0[2] + v0[3] * v0[3])) + ((v1[0] * v1[0] + v1[1] * v1[1]) + (v1[2] * v1[2] + v1[3] * v1[3]));
                    pg8::u32x4 w; w.x = pg8::cvt_pk_bf16(v0[0], v0[1]); w.y = pg8::cvt_pk_bf16(v0[2], v0[3]); w.z = pg8::cvt_pk_bf16(v1[0], v1[1]); w.w = pg8::cvt_pk_bf16(v1[2], v1[3]);
                    *(pg8::u32x4*)(H + off + bj * 128) = w; }
                ss += __shfl_xor(ss, 16); ss += __shfl_xor(ss, 32);
                if (fq == 0) ssq[(size_t)row * 64 + u.pn * 4 + wc] = ss; }
            asm volatile("" ::: "memory");
        }
    }
};
struct EpiRes4 {
    static constexpr bool PERM = true;
    bf16* H;
    __device__ __forceinline__ void operator()(const pg8::f32x4 (&acc)[2][2][4][2], const pg8::Unit& u, int wr, int wc, int fr, int fq) const {
        const int row0 = u.pm * 256 + wr * 64 + fr, col0 = u.pn * 256 + wc * 32 + 8 * fq;
#pragma unroll
        for (int ai = 0; ai < 2; ++ai) {
            pg8::u32x4 r[4][2];
#pragma unroll
            for (int m = 0; m < 4; ++m) { const size_t off = (size_t)(row0 + ai * 128 + m * 16) * D + col0;
#pragma unroll
                for (int bj = 0; bj < 2; ++bj) r[m][bj] = *(const pg8::u32x4*)(H + off + bj * 128); }
#pragma unroll
            for (int m = 0; m < 4; ++m) { const size_t off = (size_t)(row0 + ai * 128 + m * 16) * D + col0;
#pragma unroll
                for (int bj = 0; bj < 2; ++bj) { const pg8::u32x4 h = r[m][bj]; const pg8::f32x4 a0 = acc[ai][bj][m][0], a1 = acc[ai][bj][m][1];
                    pg8::u32x4 w; w.x = pg8::cvt_pk_bf16(bf_lo(h.x) + a0[0], bf_hi(h.x) + a0[1]); w.y = pg8::cvt_pk_bf16(bf_lo(h.y) + a0[2], bf_hi(h.y) + a0[3]);
                    w.z = pg8::cvt_pk_bf16(bf_lo(h.z) + a1[0], bf_hi(h.z) + a1[1]); w.w = pg8::cvt_pk_bf16(bf_lo(h.w) + a1[2], bf_hi(h.w) + a1[3]);
                    *(pg8::u32x4*)(H + off + bj * 128) = w; } }
            asm volatile("" ::: "memory");
        }
    }
};
template <int CTRL> __device__ __forceinline__ float dppf(float v) { return __builtin_bit_cast(float, __builtin_amdgcn_update_dpp(0, __builtin_bit_cast(int, v), CTRL, 0xf, 0xf, true)); }
struct EpiUp {
    static constexpr bool PERM = true;
    bf16* ACT; float* SIDE; const float* cw; const float* cb; const LAS float* rst; int pm0; const float* rstg;
    __device__ __forceinline__ void operator()(const pg8::f32x4 (&acc)[2][2][4][2], const pg8::Unit& u, int wr, int wc, int fr, int fq) const {
        const int strip = u.pm * 2 + wr;
        const int gc0 = u.pn * 128 + wc * 32 + 8 * fq;
        float* side = SIDE + (size_t)strip * 4 * NUP;
        float rs[8];
#pragma unroll
        for (int g = 0; g < 8; ++g) rs[g] = ((unsigned)(u.pm - pm0) < 8u) ? rst[(u.pm - pm0) * 256 + wr * 128 + g * 16 + fr] : __hip_atomic_load(rstg + u.pm * 256 + wr * 128 + g * 16 + fr, __ATOMIC_RELAXED, __HIP_MEMORY_SCOPE_AGENT);
        unsigned pk[8][2];
#pragma unroll
        for (int n = 0; n < 2; ++n) {
            const int gc = gc0 + 4 * n;
            const pg8::f32x4 wg0 = *(const pg8::f32x4*)(cw + gc), wg1 = *(const pg8::f32x4*)(cw + NUP + gc), wg2 = *(const pg8::f32x4*)(cw + 2 * NUP + gc), bg = *(const pg8::f32x4*)(cb + gc);
            const pg8::f32x4 wv0 = *(const pg8::f32x4*)(cw + DFF + gc), wv1 = *(const pg8::f32x4*)(cw + NUP + DFF + gc), wv2 = *(const pg8::f32x4*)(cw + 2 * NUP + DFF + gc), bv = *(const pg8::f32x4*)(cb + DFF + gc);
            pg8::f32x4 PG = (pg8::f32x4){0.f, 0.f, 0.f, 0.f}, PV = PG;
#pragma unroll
            for (int g = 0; g < 8; ++g) {
                const pg8::f32x4 Gv = acc[g >> 2][0][g & 3][n] * rs[g], Vv = acc[g >> 2][1][g & 3][n] * rs[g];
                if (g == 0 && fr < 2) { *(pg8::f32x4*)(side + (size_t)fr * NUP + gc) = Gv; *(pg8::f32x4*)(side + (size_t)fr * NUP + DFF + gc) = Vv; }
                if (g == 7 && fr >= 14) { *(pg8::f32x4*)(side + (size_t)(fr - 12) * NUP + gc) = Gv; *(pg8::f32x4*)(side + (size_t)(fr - 12) * NUP + DFF + gc) = Vv; }
                float o[4];
#pragma unroll
                for (int j = 0; j < 4; ++j) {
                    const float g1 = dppf<0x111>(Gv[j]) + dppf<0x10F>(PG[j]);
                    const float g2 = dppf<0x112>(Gv[j]) + dppf<0x10E>(PG[j]);
                    const float v1 = dppf<0x111>(Vv[j]) + dppf<0x10F>(PV[j]);
                    const float v2 = dppf<0x112>(Vv[j]) + dppf<0x10E>(PV[j]);
                    const float cg = bg[j] + wg2[j] * Gv[j] + wg1[j] * g1 + wg0[j] * g2;
                    const float cv = bv[j] + wv2[j] * Vv[j] + wv1[j] * v1 + wv0[j] * v2;
                    o[j] = siluf_(cg) * cv;
                }
                pk[g][0] = (n == 0) ? pg8::cvt_pk_bf16(o[0], o[1]) : pk[g][0]; pk[g][1] = (n == 0) ? pg8::cvt_pk_bf16(o[2], o[3]) : pk[g][1];
                if (n == 1) { pg8::u32x4 w; w.x = pk[g][0]; w.y = pk[g][1]; w.z = pg8::cvt_pk_bf16(o[0], o[1]); w.w = pg8::cvt_pk_bf16(o[2], o[3]);
                    *(pg8::u32x4*)(ACT + (size_t)(strip * 128 + g * 16 + fr) * DFF + gc0) = w; }
                PG = Gv; PV = Vv;
            }
        }
    }
};

#define LBAR() do { asm volatile("s_waitcnt lgkmcnt(0)" ::: "memory"); __builtin_amdgcn_s_barrier(); asm volatile("" ::: "memory"); } while (0)
typedef short bf16x8_t __attribute__((ext_vector_type(8)));
__device__ __forceinline__ float row16_sum(float v) {
    v += __builtin_bit_cast(float, __builtin_amdgcn_update_dpp(0, __builtin_bit_cast(int, v), 0x128, 0xf, 0xf, false));
    v += __builtin_bit_cast(float, __builtin_amdgcn_update_dpp(0, __builtin_bit_cast(int, v), 0x124, 0xf, 0xf, false));
    v += __builtin_bit_cast(float, __builtin_amdgcn_update_dpp(0, __builtin_bit_cast(int, v), 0x122, 0xf, 0xf, false));
    v += __builtin_bit_cast(float, __builtin_amdgcn_update_dpp(0, __builtin_bit_cast(int, v), 0x121, 0xf, 0xf, false));
    return v;
}
__device__ __forceinline__ void hgrn_unit(Frame& F, int b, int h) {
    constexpr int QS = 0, KS = 16384, GS = 32768, KT = 49152, VT = 67584, TS = 144, PS = 86016, OS = 95232, OSS = 528, SEGS = 129024, DEC = 133120;
    LAS unsigned char* L = F.lds;
    const int tid = F.tid, lane = F.lane, w = F.wave, quad = lane >> 4, l16 = lane & 15;
    const int vrow = 16 * w + l16;
    f32x4 Sacc[8];
#pragma unroll
    for (int kt = 0; kt < 8; ++kt) Sacc[kt] = (f32x4){0.f, 0.f, 0.f, 0.f};
    for (int i = tid; i < 9216 / 4; i += 512) ((LAS unsigned*)(L + PS))[i] = 0u;
    const int t_o = tid >> 3, part = tid & 7;
    f32x4 nw[4];
#pragma unroll
    for (int i = 0; i < 4; ++i) nw[i] = *(const GAS f32x4*)(F.hg_norm_w + h * HD + 16 * part + 4 * i);
    const bf16* src = F.PROJ + (size_t)(b * SEQ) * NIN + h * HD;
    v4u pre[2][4];
#pragma unroll
    for (int it = 0; it < 2; ++it) { const int p = tid + 512 * it, row = p >> 4, c = p & 15;
#pragma unroll
        for (int a = 0; a < 4; ++a) pre[it][a] = *(const GAS v4u*)(src + (size_t)row * NIN + a * HGW + c * 8); }
    const int cbase = (((lane >> 2) ^ (8 * (w & 1))) << 4), boff = (lane & 3) * 4;
    for (int ch = 0; ch < SEQ / 64; ++ch) {
        const int t0 = 64 * ch;
#pragma unroll
        for (int it = 0; it < 2; ++it) { const int p = tid + 512 * it, row = p >> 4, c = p & 15; const int sw = (c ^ (row & 15)) * 16;
            *(LAS v4u*)(L + QS + row * 256 + sw) = pre[it][0]; *(LAS v4u*)(L + KS + row * 256 + sw) = pre[it][1]; *(LAS v4u*)(L + GS + row * 256 + c * 16) = pre[it][3];
            const v4u vv = pre[it][2]; LAS unsigned short* vt = (LAS unsigned short*)(L + VT + (8 * c) * TS + row * 2);
            vt[0 * (TS / 2)] = (unsigned short)(vv.x & 0xffffu); vt[1 * (TS / 2)] = (unsigned short)(vv.x >> 16); vt[2 * (TS / 2)] = (unsigned short)(vv.y & 0xffffu); vt[3 * (TS / 2)] = (unsigned short)(vv.y >> 16);
            vt[4 * (TS / 2)] = (unsigned short)(vv.z & 0xffffu); vt[5 * (TS / 2)] = (unsigned short)(vv.z >> 16); vt[6 * (TS / 2)] = (unsigned short)(vv.w & 0xffffu); vt[7 * (TS / 2)] = (unsigned short)(vv.w >> 16); }
        LBAR();
        if (ch + 1 < SEQ / 64) {
#pragma unroll
            for (int it = 0; it < 2; ++it) { const int p = tid + 512 * it, row = p >> 4, c = p & 15;
#pragma unroll
                for (int a = 0; a < 4; ++a) pre[it][a] = *(const GAS v4u*)(src + (size_t)(t0 + 64 + row) * NIN + a * HGW + c * 8); } }
        { float k0[8], k1[8], P0[8], P1[8]; float r0 = 1.f, r1 = 1.f;
#pragma unroll
          for (int i = 0; i < 8; ++i) { const unsigned kk = *(const LAS unsigned*)(L + KS + (8 * w + i) * 256 + (cbase ^ (i << 4)) + boff);
              k0[i] = bf_lo(kk); k1[i] = bf_hi(kk); r0 *= (1.0f - k0[i]); r1 *= (1.0f - k1[i]); P0[i] = r0; P1[i] = r1; }
          *(LAS f32x2*)(L + SEGS + (w * 128 + 2 * lane) * 4) = (f32x2){r0, r1};
          LBAR();
          float b0 = 1.f, b1 = 1.f, tt0 = 1.f, tt1 = 1.f;
#pragma unroll
          for (int w2 = 0; w2 < 8; ++w2) { const f32x2 sg = *(const LAS f32x2*)(L + SEGS + (w2 * 128 + 2 * lane) * 4); tt0 *= sg.x; tt1 *= sg.y; if (w2 < w) { b0 *= sg.x; b1 *= sg.y; } }
          unsigned kh0[4], kh1[4];
#pragma unroll
          for (int i = 0; i < 8; i += 2) { float hv0[2], hv1[2];
#pragma unroll
              for (int u = 0; u < 2; ++u) { const int ii = i + u; const int ad = (8 * w + ii) * 256 + (cbase ^ (ii << 4)) + boff;
                  const float e0 = b0 * P0[ii], e1 = b1 * P1[ii];
                  const float i0 = __builtin_amdgcn_rcpf(fmaxf(e0, 1e-35f)), i1 = __builtin_amdgcn_rcpf(fmaxf(e1, 1e-35f));
                  const unsigned qq = *(const LAS unsigned*)(L + QS + ad);
                  *(LAS unsigned*)(L + QS + ad) = cvtpk(bf_lo(qq) * e0, bf_hi(qq) * e1);
                  const float kt0 = k0[ii] * i0, kt1 = k1[ii] * i1;
                  *(LAS unsigned*)(L + KS + ad) = cvtpk(kt0, kt1);
                  hv0[u] = kt0 * tt0; hv1[u] = kt1 * tt1; }
              kh0[i >> 1] = cvtpk(hv0[0], hv0[1]); kh1[i >> 1] = cvtpk(hv1[0], hv1[1]); }
          *(LAS v4u*)(L + KT + (2 * lane) * TS + 16 * w) = (v4u){kh0[0], kh0[1], kh0[2], kh0[3]};
          *(LAS v4u*)(L + KT + (2 * lane + 1) * TS + 16 * w) = (v4u){kh1[0], kh1[1], kh1[2], kh1[3]};
          if (w == 0) *(LAS f32x2*)(L + DEC + (2 * lane) * 4) = (f32x2){tt0, tt1}; }
        LBAR();
#pragma unroll
        for (int rep = 0; rep < 2; ++rep) { const int idx = w + 8 * rep;
            if (idx < 10) { const int ti = (idx >= 6) ? 3 : (idx >= 3) ? 2 : (idx >= 1) ? 1 : 0, si = idx - ((ti * (ti + 1)) >> 1);
                f32x4 acc = (f32x4){0.f, 0.f, 0.f, 0.f};
#pragma unroll
                for (int ks = 0; ks < 4; ++ks) { const int rk = 16 * si + l16, rq = 16 * ti + l16;
                    const bf16x8_t Ak = *(const LAS bf16x8_t*)(L + KS + rk * 256 + (((4 * ks + quad) ^ (rk & 15)) * 16));
                    const bf16x8_t Bq = *(const LAS bf16x8_t*)(L + QS + rq * 256 + (((4 * ks + quad) ^ (rq & 15)) * 16));
                    acc = __builtin_amdgcn_mfma_f32_16x16x32_bf16(Ak, Bq, acc, 0, 0, 0); }
                if (si == ti) {
#pragma unroll
                    for (int j = 0; j < 4; ++j) acc[j] = (4 * quad + j > l16) ? 0.f : acc[j]; }
                *(LAS v2u*)(L + PS + (16 * ti + l16) * TS + (16 * si + 4 * quad) * 2) = (v2u){cvtpk(acc[0], acc[1]), cvtpk(acc[2], acc[3])}; } }
        f32x4 O[4];
        { unsigned Sb[8][2];
#pragma unroll
          for (int kt = 0; kt < 8; ++kt) { Sb[kt][0] = cvtpk(Sacc[kt][0], Sacc[kt][1]); Sb[kt][1] = cvtpk(Sacc[kt][2], Sacc[kt][3]); }
#pragma unroll
          for (int ti = 0; ti < 4; ++ti) { O[ti] = (f32x4){0.f, 0.f, 0.f, 0.f};
#pragma unroll
              for (int ks = 0; ks < 4; ++ks) { const int rq = 16 * ti + l16;
                  const bf16x8_t Aq = *(const LAS bf16x8_t*)(L + QS + rq * 256 + (((4 * ks + quad) ^ (rq & 15)) * 16));
                  const v4u Bu = (v4u){Sb[2 * ks][0], Sb[2 * ks][1], Sb[2 * ks + 1][0], Sb[2 * ks + 1][1]};
                  O[ti] = __builtin_amdgcn_mfma_f32_16x16x32_bf16(Aq, __builtin_bit_cast(bf16x8_t, Bu), O[ti], 0, 0, 0); } } }
        const v4u g0 = *(const LAS v4u*)(L + GS + t_o * 256 + part * 32), g1 = *(const LAS v4u*)(L + GS + t_o * 256 + part * 32 + 16);
        LBAR();
        { bf16x8_t Bv[2];
#pragma unroll
          for (int p = 0; p < 2; ++p) Bv[p] = *(const LAS bf16x8_t*)(L + VT + vrow * TS + (32 * p + 8 * quad) * 2);
#pragma unroll
          for (int ti = 0; ti < 4; ++ti)
#pragma unroll
              for (int p = 0; p < 2; ++p) if (2 * p <= ti) { const bf16x8_t Ap = *(const LAS bf16x8_t*)(L + PS + (16 * ti + l16) * TS + (32 * p + 8 * quad) * 2);
                  O[ti] = __builtin_amdgcn_mfma_f32_16x16x32_bf16(Ap, Bv[p], O[ti], 0, 0, 0); }
#pragma unroll
          for (int kt = 0; kt < 8; ++kt) { const int kb = 32 * (kt >> 1) + 4 * (kt & 1);
              const f32x4 d4 = *(const LAS f32x4*)(L + DEC + (kb + 8 * quad) * 4); Sacc[kt] = Sacc[kt] * d4;
              const int kdr = kb + 8 * (l16 >> 2) + (l16 & 3);
#pragma unroll
              for (int ks = 0; ks < 2; ++ks) { const bf16x8_t Ak = *(const LAS bf16x8_t*)(L + KT + kdr * TS + (32 * ks + 8 * quad) * 2);
                  Sacc[kt] = __builtin_amdgcn_mfma_f32_16x16x32_bf16(Ak, Bv[ks], Sacc[kt], 0, 0, 0); } } }
#pragma unroll
        for (int ti = 0; ti < 4; ++ti)
#pragma unroll
            for (int j = 0; j < 4; ++j) *(LAS float*)(L + OS + (16 * ti + 4 * quad + j) * OSS + vrow * 4) = O[ti][j];
        LBAR();
        { const LAS f32x4* op = (const LAS f32x4*)(L + OS + t_o * OSS + part * 64);
          const f32x4 o0 = op[0], o1 = op[1], o2 = op[2], o3 = op[3];
          float ss = ((o0.x * o0.x + o0.y * o0.y) + (o0.z * o0.z + o0.w * o0.w)) + ((o1.x * o1.x + o1.y * o1.y) + (o1.z * o1.z + o1.w * o1.w))
                   + ((o2.x * o2.x + o2.y * o2.y) + (o2.z * o2.z + o2.w * o2.w)) + ((o3.x * o3.x + o3.y * o3.y) + (o3.z * o3.z + o3.w * o3.w));
          ss += __shfl_xor(ss, 1); ss += __shfl_xor(ss, 2); ss += __shfl_xor(ss, 4);
          const float rstd = __builtin_amdgcn_rsqf(ss * (1.0f / HD) + EPS);
          const f32x4 r0 = o0 * rstd * nw[0] * (f32x4){bf_lo(g0.x), bf_hi(g0.x), bf_lo(g0.y), bf_hi(g0.y)}, r1 = o1 * rstd * nw[1] * (f32x4){bf_lo(g0.z), bf_hi(g0.z), bf_lo(g0.w), bf_hi(g0.w)};
          const f32x4 r2 = o2 * rstd * nw[2] * (f32x4){bf_lo(g1.x), bf_hi(g1.x), bf_lo(g1.y), bf_hi(g1.y)}, r3 = o3 * rstd * nw[3] * (f32x4){bf_lo(g1.z), bf_hi(g1.z), bf_lo(g1.w), bf_hi(g1.w)};
          GAS v4u* dst = (GAS v4u*)(F.MIX + (size_t)(b * SEQ + t0 + t_o) * D + LRUW + h * HD + 16 * part);
          dst[0] = (v4u){cvtpk(r0.x, r0.y), cvtpk(r0.z, r0.w), cvtpk(r1.x, r1.y), cvtpk(r1.z, r1.w)}; dst[1] = (v4u){cvtpk(r2.x, r2.y), cvtpk(r2.z, r2.w), cvtpk(r3.x, r3.y), cvtpk(r3.z, r3.w)}; }
    }
    __syncthreads();
}

__device__ __forceinline__ void lru_unit(Frame& F, int b, int blk) {
    constexpr int XR = 0, XF = 17408, XH = 50176, XHS = 272, AS = 67584, US = 100352, SGA = 133120, SGU = SGA + 2048, HST = SGU + 2048;
    LAS unsigned char* L = F.lds;
    const int tid = F.tid, lane = F.lane, w = F.wave, quad = lane >> 4, l16 = lane & 15;
    const int e_own = tid & 127, seg = tid >> 7, chc = blk * LBD + e_own;
    const int em = 16 * w + l16, chm = blk * LBD + em;
    const float cw0 = F.lru_conv_w[chc], cw1 = F.lru_conv_w[LRUW + chc], cw2 = F.lru_conv_w[2 * LRUW + chc], cw3 = F.lru_conv_w[3 * LRUW + chc], cbv = F.lru_conv_b[chc];
    const float nba = -1.44269504089f * F.lru_ba[chm], nbx = -1.44269504089f * F.lru_bx[chm];
    const float lam = F.lru_lambda[chm];
    const float c2 = 16.0f * (fmaxf(-lam, 0.f) + log1pf(expf(-fabsf(lam))));
    bf16x8_t Bwa[4], Bwx[4];
#pragma unroll
    for (int ks = 0; ks < 4; ++ks)
#pragma unroll
        for (int i = 0; i < 8; ++i) { const int d = 32 * ks + 8 * quad + i;
            Bwa[ks][i] = (short)f2bf(F.lru_wa[((size_t)blk * LBD + d) * LBD + em]); Bwx[ks][i] = (short)f2bf(F.lru_wx[((size_t)blk * LBD + d) * LBD + em]); }
    if (tid < 256) ((LAS float*)(L + HST))[tid] = 0.f;
    const bf16* xsrc = F.PROJ + (size_t)(b * SEQ) * NIN + 4 * HGW + blk * LBD;
    const bf16* ysrc = xsrc + LRUW;
    v4u px[3]; unsigned short py[16];
#pragma unroll
    for (int it = 0; it < 3; ++it) { const int p = tid + 512 * it; px[it] = (v4u){0u, 0u, 0u, 0u}; if (p < 67 * 16) { const int row = p >> 4, s16 = p & 15, t = row - 3; if (t >= 0) px[it] = *(const GAS v4u*)(xsrc + (size_t)t * NIN + s16 * 8); } }
#pragma unroll
    for (int i = 0; i < 16; ++i) py[i] = *(const GAS unsigned short*)(ysrc + (size_t)(16 * seg + i) * NIN + e_own);
    for (int c = 0; c < SEQ / 64; ++c) {
        const int t0 = 64 * c;
#pragma unroll
        for (int it = 0; it < 3; ++it) { const int p = tid + 512 * it; if (p < 67 * 16) { const int row = p >> 4, s16 = p & 15; *(LAS v4u*)(L + XR + row * 256 + s16 * 16) = px[it]; } }
        LBAR();
        if (c + 1 < SEQ / 64) {
#pragma unroll
            for (int it = 0; it < 3; ++it) { const int p = tid + 512 * it; if (p < 67 * 16) { const int row = p >> 4, s16 = p & 15; px[it] = *(const GAS v4u*)(xsrc + (size_t)(t0 + 61 + row) * NIN + s16 * 8); } }
        }
        { const LAS unsigned short* xr = (const LAS unsigned short*)(L + XR) + e_own;
          float x0 = __builtin_bit_cast(float, (unsigned)xr[(16 * seg + 0) * 128] << 16), x1 = __builtin_bit_cast(float, (unsigned)xr[(16 * seg + 1) * 128] << 16), x2 = __builtin_bit_cast(float, (unsigned)xr[(16 * seg + 2) * 128] << 16);
#pragma unroll
          for (int i = 0; i < 16; ++i) { const int t = 16 * seg + i; const float x3 = __builtin_bit_cast(float, (unsigned)xr[(t + 3) * 128] << 16);
              const float xb = cbv + cw0 * x0 + cw1 * x1 + cw2 * x2 + cw3 * x3;
              ((LAS float*)(L + XF))[t * 128 + e_own] = xb; *(LAS unsigned short*)(L + XH + t * XHS + e_own * 2) = (unsigned short)cvtpk(xb, xb);
              x0 = x1; x1 = x2; x2 = x3; } }
        LBAR();
#pragma unroll 1
        for (int mt = 0; mt < 4; ++mt) {
            f32x4 R = (f32x4){0.f, 0.f, 0.f, 0.f}, I = R;
#pragma unroll
            for (int ks = 0; ks < 4; ++ks) { const bf16x8_t A = *(const LAS bf16x8_t*)(L + XH + (16 * mt + l16) * XHS + (32 * ks + 8 * quad) * 2);
                R = __builtin_amdgcn_mfma_f32_16x16x32_bf16(A, Bwa[ks], R, 0, 0, 0); I = __builtin_amdgcn_mfma_f32_16x16x32_bf16(A, Bwx[ks], I, 0, 0, 0); }
            f32x4 e1, e2;
#pragma unroll
            for (int j = 0; j < 4; ++j) { e1[j] = __builtin_amdgcn_exp2f(R[j] * -1.44269504089f + nba); e2[j] = __builtin_amdgcn_exp2f(I[j] * -1.44269504089f + nbx); }
            const f32x4 d1 = e1 + 1.0f, d2 = e2 + 1.0f, dd = d1 * d2;
            f32x4 inv;
#pragma unroll
            for (int j = 0; j < 4; ++j) inv[j] = __builtin_amdgcn_rcpf(dd[j]);
            const f32x4 r = inv * d2, ig = inv * d1, z = r * c2;
            f32x4 av = 1.0f + z * (-0.5f + z * (0.125f + z * ((-1.0f / 48.0f) + z * ((1.0f / 384.0f) + z * (-1.0f / 3840.0f)))));
            f32x4 om = z * (1.0f + z * (-0.5f + z * ((1.0f / 6.0f) + z * ((-1.0f / 24.0f) + z * ((1.0f / 120.0f) + z * (-1.0f / 720.0f))))));
            const bool big = (z[0] > 0.35f) | (z[1] > 0.35f) | (z[2] > 0.35f) | (z[3] > 0.35f);
            if (__builtin_amdgcn_ballot_w64(big) != 0ull) {
#pragma unroll
                for (int j = 0; j < 4; ++j) if (z[j] > 0.35f) { av[j] = fexp(-0.5f * z[j]); om[j] = 1.0f - av[j] * av[j]; } }
            f32x4 mult;
#pragma unroll
            for (int j = 0; j < 4; ++j) mult[j] = __builtin_amdgcn_sqrtf(om[j]);
            if (c == 0 && mt == 0 && quad == 0) mult[0] = 1.0f;
            const LAS float* xf = (const LAS float*)(L + XF) + (16 * mt + 4 * quad) * 128 + em;
            const f32x4 xbv = (f32x4){xf[0], xf[128], xf[256], xf[384]};
            const f32x4 uv = xbv * ig * mult;
            LAS float* ap = (LAS float*)(L + AS) + (16 * mt + 4 * quad) * 128 + em; LAS float* up = (LAS float*)(L + US) + (16 * mt + 4 * quad) * 128 + em;
#pragma unroll
            for (int j = 0; j < 4; ++j) { ap[j * 128] = av[j]; up[j * 128] = uv[j]; } }
        LBAR();
        { const LAS float* as = (const LAS float*)(L + AS) + e_own; const LAS float* us = (const LAS float*)(L + US) + e_own;
          float Aacc = 1.0f, Uacc = 0.0f;
#pragma unroll
          for (int i = 0; i < 16; ++i) { const int t = 16 * seg + i; const float a = as[t * 128], u = us[t * 128]; Uacc = a * Uacc + u; Aacc *= a; }
          ((LAS float*)(L + SGA))[seg * 128 + e_own] = Aacc; ((LAS float*)(L + SGU))[seg * 128 + e_own] = Uacc;
          LBAR();
          float h = ((LAS float*)(L + HST))[(c & 1) * 128 + e_own];
#pragma unroll
          for (int s2 = 0; s2 < 3; ++s2) if (s2 < seg) h = ((LAS float*)(L + SGA))[s2 * 128 + e_own] * h + ((LAS float*)(L + SGU))[s2 * 128 + e_own];
#pragma unroll
          for (int i = 0; i < 16; ++i) { const int t = 16 * seg + i; const float a = as[t * 128], u = us[t * 128]; h = a * h + u;
              ((LAS float*)(L + AS))[t * 128 + e_own] = h * __builtin_bit_cast(float, (unsigned)py[i] << 16); }
          if (seg == 3) ((LAS float*)(L + HST))[((c + 1) & 1) * 128 + e_own] = h;
          if (c + 1 < SEQ / 64) {
#pragma unroll
              for (int i = 0; i < 16; ++i) py[i] = *(const GAS unsigned short*)(ysrc + (size_t)(t0 + 64 + 16 * seg + i) * NIN + e_own); } }
        LBAR();
        { const int t = tid >> 3, part = tid & 7; const LAS f32x4* o4 = (const LAS f32x4*)(L + AS + (t * 128 + 16 * part) * 4);
          const f32x4 o0 = o4[0], o1 = o4[1], o2 = o4[2], o3 = o4[3];
          float ss = ((o0.x * o0.x + o0.y * o0.y) + (o0.z * o0.z + o0.w * o0.w)) + ((o1.x * o1.x + o1.y * o1.y) + (o1.z * o1.z + o1.w * o1.w))
                   + ((o2.x * o2.x + o2.y * o2.y) + (o2.z * o2.z + o2.w * o2.w)) + ((o3.x * o3.x + o3.y * o3.y) + (o3.z * o3.z + o3.w * o3.w));
          ss += __shfl_xor(ss, 1); ss += __shfl_xor(ss, 2); ss += __shfl_xor(ss, 4);
          const size_t row = (size_t)(b * SEQ + t0 + t);
          v4u p0, p1; p0.x = cvtpk(o0.x, o0.y); p0.y = cvtpk(o0.z, o0.w); p0.z = cvtpk(o1.x, o1.y); p0.w = cvtpk(o1.z, o1.w); p1.x = cvtpk(o2.x, o2.y); p1.y = cvtpk(o2.z, o2.w); p1.z = cvtpk(o3.x, o3.y); p1.w = cvtpk(o3.z, o3.w);
          GAS v4u* dst = (GAS v4u*)(F.MIX + row * D + blk * LBD + 16 * part); dst[0] = p0; dst[1] = p1;
          if (part == 0) F.SSQL[(size_t)blk * M + row] = ss; }
    }
    __syncthreads();
}

constexpr int N_PHASES = 10;
struct Args { const float* in[20]; float* out; unsigned char* ws; int ph_lo, ph_hi; };
__global__ void __launch_bounds__(NWAVES * 64, 2) fwd_kernel(Args args) {
    extern __shared__ __attribute__((aligned(16))) unsigned char lds[];
    Frame F;
    F.lds = (LAS unsigned char*)lds;
    F.MISC = (volatile LAS unsigned*)(F.lds + MISC_OFF);
    F.tid = threadIdx.x; F.lane = F.tid & 63; F.wave = __builtin_amdgcn_readfirstlane(F.tid >> 6);
    F.G = gridDim.x; { const int bx = blockIdx.x; F.vcu = (F.G % 8 == 0) ? (bx % 8) * (F.G / 8) + bx / 8 : bx; }
    unsigned char* ws = args.ws;
    F.ctl = (gu32*)(ws + WS_CTL);
    F.x = args.in[0]; F.ln1_w = args.in[1]; F.w_in = args.in[2]; F.lb_gamma = args.in[3]; F.hg_norm_w = args.in[4]; F.lru_conv_w = args.in[5]; F.lru_conv_b = args.in[6];
    F.lru_wa = args.in[7]; F.lru_ba = args.in[8]; F.lru_wx = args.in[9]; F.lru_bx = args.in[10]; F.lru_lambda = args.in[11]; F.lru_norm_w = args.in[12]; F.w_out = args.in[13];
    F.ln2_w = args.in[14]; F.w_up = args.in[15]; F.ffn_conv_w = args.in[16]; F.ffn_conv_b = args.in[17]; F.w_down = args.in[18]; F.final_norm_w = args.in[19]; F.out = args.out;
    F.Win_t = (bf16*)(ws + WS_WIN); F.Wout_t = (bf16*)(ws + WS_WOUT); F.Wup_t = (bf16*)(ws + WS_WUP); F.Wdn_t = (bf16*)(ws + WS_WDN);
    F.XN = (bf16*)(ws + WS_XN); F.PROJ = (bf16*)(ws + WS_PROJ); F.MIX = (bf16*)(ws + WS_MIX); F.ACT = (bf16*)(ws + WS_ACT);
    F.SIDE = (float*)(ws + WS_SIDE); F.SSQL = (float*)(ws + WS_SSQL); F.SSQ2 = (float*)(ws + WS_SSQ2); F.RSTG = (float*)(ws + WS_RSTG);
    for (int u = F.tid; u < (LDS_BYTES - LDSCTL_OFF) / 4; u += NWAVES * 64) ((LAS unsigned*)(F.lds + LDSCTL_OFF))[u] = 0u;
    __syncthreads();
    XcdBarrier bar; bar.bar = (unsigned*)(F.ctl + CW_BAR); bar.x = 0; bar.st = nullptr;
    if (MK_N_LAUNCHES == 1) bar = xcd_barrier_post((unsigned*)(F.ctl + CW_BAR), F.MISC + 8);
    const int lo = args.ph_lo, hi = args.ph_hi;
#define IN(k) (lo <= (k) && (k) < hi)
#define SEAM(k) do { if (IN(k) && IN((k) + 1)) xcd_barrier(bar); } while (0)
    const int gw = F.vcu * NWAVES + F.wave, NGW = F.G * NWAVES;

    if (IN(0)) { p0_prologue(F); } SEAM(0);
    if (IN(1)) { pg8::Gemm g{F.XN, F.Win_t, M, NIN, D}; pg8::StaticOrder S; S.init(M, NIN, F.G, (int)blockIdx.x);
        EpiProj E{F.PROJ, F.lb_gamma};
        pg8::gemm_phase<EpiProj, pg8::StaticOrder, PG8_ALIGN, PG8_SP2, false>(F.lds + RING_OFF, g, S, E); } SEAM(1);
    if (IN(2)) { const int half = F.G >> 1;
        if (F.vcu < half) { for (int u = F.vcu; u < 128; u += half) hgrn_unit(F, u >> 4, u & 15); }
        else { for (int u = F.vcu - half; u < 128; u += half) lru_unit(F, u >> 4, u & 15); }
        p_convert_w<1>(F); }
    if (IN(2) && IN(4)) xcd_barrier(bar);
    if (IN(4)) { LAS float* RSTL = (LAS float*)(F.lds + RING_BYTES); const int x8 = (int)(blockIdx.x & 7);
        for (int r = F.tid; r < 2048; r += NWAVES * 64) { const size_t row = (size_t)2048 * x8 + r; float sacc = 0.f;
#pragma unroll
            for (int q = 0; q < 16; ++q) sacc += F.SSQL[(size_t)q * M + row];
            RSTL[r] = __builtin_amdgcn_rsqf(sacc * (1.0f / LRUW) + EPS); }
        __syncthreads();
        pg8::Gemm g{F.MIX, F.Wout_t, M, D, D}; pg8::StaticOrder S; S.init(M, D, F.G, (int)blockIdx.x);
        EpiRes2 E{F.x, F.XN, F.SSQ2};
        pg8::gemm_phase<EpiRes2, pg8::StaticOrder, PG8_ALIGN, PG8_SP2, false, true>(F.lds + RING_OFF, g, S, E, RSTL, 8 * x8);
        p_convert_w<2>(F); }
    if (IN(4) && IN(6)) xcd_barrier(bar);
    if (IN(6)) { LAS float* RST = (LAS float*)(F.lds + RING_BYTES); const int x8 = (int)(blockIdx.x & 7);
        for (int r = F.tid; r < 2048; r += NWAVES * 64) { const GAS f32x4* p = (const GAS f32x4*)(F.SSQ2 + (size_t)(2048 * x8 + r) * 64); float sacc = 0.f;
#pragma unroll
            for (int q = 0; q < 16; ++q) { const f32x4 v = p[q]; sacc += (v.x + v.y) + (v.z + v.w); }
            const float rv = __builtin_amdgcn_rsqf(sacc * (1.0f / D) + EPS); RST[r] = rv;
            if (F.G != 256 || (r >> 6) == (int)(blockIdx.x >> 3)) __hip_atomic_store(F.RSTG + (size_t)2048 * x8 + r, rv, RLX_AGENT); }
        __syncthreads();
        pg8::Gemm g{F.XN, F.Wup_t, M, NUP, D}; pg8::DynTailOrder S; S.init2(M, NUP, F.G, (int)blockIdx.x, (unsigned*)(F.ctl + 32), (volatile LAS unsigned*)(F.MISC + 24));
        EpiUp E{F.ACT, F.SIDE, F.ffn_conv_w, F.ffn_conv_b, RST, 8 * x8, F.RSTG};
        pg8::gemm_phase<EpiUp, pg8::DynTailOrder, PG8_ALIGN, PG8_SP2, true>(F.lds + RING_OFF, g, S, E);
        p_convert_wdown(F, F.vcu, F.G); }
    SEAM(6);
    if (IN(7)) { const size_t total = (size_t)NSTRIP * DFF;
        for (size_t i = (size_t)F.vcu * 512 + F.tid; i < total; i += (size_t)F.G * 512) { const int s = (int)(i / DFF), c = (int)(i % DFF);
            if ((s & 15) == 0) continue;
            const float* sp = F.SIDE + (size_t)(s - 1) * 4 * NUP; const float* sc = F.SIDE + (size_t)s * 4 * NUP;
            const float gm2 = sp[2 * (size_t)NUP + c], gm1 = sp[3 * (size_t)NUP + c], g0 = sc[c], g1 = sc[(size_t)NUP + c];
            const float vm2 = sp[2 * (size_t)NUP + DFF + c], vm1 = sp[3 * (size_t)NUP + DFF + c], v0 = sc[DFF + c], v1 = sc[(size_t)NUP + DFF + c];
            const float wg0 = F.ffn_conv_w[c], wg1 = F.ffn_conv_w[NUP + c], wg2 = F.ffn_conv_w[2 * NUP + c], bg = F.ffn_conv_b[c];
            const float wv0 = F.ffn_conv_w[DFF + c], wv1 = F.ffn_conv_w[NUP + DFF + c], wv2 = F.ffn_conv_w[2 * NUP + DFF + c], bv = F.ffn_conv_b[DFF + c];
            const float cg0 = bg + wg2 * g0 + wg1 * gm1 + wg0 * gm2, cv0 = bv + wv2 * v0 + wv1 * vm1 + wv0 * vm2;
            const float cg1 = bg + wg2 * g1 + wg1 * g0 + wg0 * gm1, cv1 = bv + wv2 * v1 + wv1 * v0 + wv0 * vm1;
            F.ACT[(size_t)(s * 128) * DFF + c] = (bf16)f2bf(siluf_(cg0) * cv0); F.ACT[(size_t)(s * 128 + 1) * DFF + c] = (bf16)f2bf(siluf_(cg1) * cv1); } } SEAM(7);
    if (IN(8)) { pg8::Gemm g{F.ACT, F.Wdn_t, M, D, DFF}; pg8::StaticOrder S; S.init(M, D, F.G, (int)blockIdx.x, 2);
        EpiRes4 E{F.XN};
        pg8::gemm_phase<EpiRes4, pg8::StaticOrder, PG8_ALIGN, PG8_SP2, false>(F.lds + RING_OFF, g, S, E); } SEAM(8);
    if (IN(9)) { for (int m = gw; m < M; m += NGW) rms_row_bf16_to_f32(F.lane, F.XN + (size_t)m * D, F.final_norm_w, F.out + (size_t)m * D); }
#undef IN
#undef SEAM
}

extern "C" void kernel_launch(void* const* d_in, const int* in_sizes, int n_in, void* d_out, int out_size, void* d_ws, size_t ws_size, hipStream_t stream) {
    static int grid = 0;
    if (grid == 0) {
        if (n_in != 20 || in_sizes[0] != M * D || out_size != M * D || ws_size < WS_END) { fprintf(stderr, "kernel_launch: unexpected shapes (n_in %d, in0 %d, out %d, ws %zu < %zu); nothing launched\n", n_in, n_in > 0 ? in_sizes[0] : -1, out_size, ws_size, (size_t)WS_END); grid = -1; return; }
        int dev = 0, cus = 0, per_cu = 0;
        if (hipGetDevice(&dev) != hipSuccess || hipDeviceGetAttribute(&cus, hipDeviceAttributeMultiprocessorCount, dev) != hipSuccess) { grid = -1; return; }
        if (hipFuncSetAttribute((const void*)fwd_kernel, hipFuncAttributeMaxDynamicSharedMemorySize, LDS_BYTES) != hipSuccess) { fprintf(stderr, "kernel_launch: hipFuncSetAttribute failed\n"); grid = -1; return; }
        if (hipOccupancyMaxActiveBlocksPerMultiprocessor(&per_cu, (const void*)fwd_kernel, NWAVES * 64, LDS_BYTES) != hipSuccess || per_cu < 1)
            fprintf(stderr, "kernel_launch: note: occupancy query reports %d workgroups per CU\n", per_cu);
        (void)hipGetLastError();
        grid = cus;
    }
    if (grid < 0) return;
    if (hipMemsetAsync((char*)d_ws + WS_CTL, 0, CTL_ZERO_BYTES, stream) != hipSuccess) return;
    Args a{};
    for (int i = 0; i < 20; ++i) a.in[i] = (const float*)d_in[i];
    a.out = (float*)d_out; a.ws = (unsigned char*)d_ws;
    if (MK_N_LAUNCHES == 1) { a.ph_lo = 0; a.ph_hi = N_PHASES; hipLaunchKernelGGL(fwd_kernel, dim3(grid), dim3(NWAVES * 64), LDS_BYTES, stream, a); }
    else for (int p = 0; p < N_PHASES; ++p) { a.ph_lo = p; a.ph_hi = p + 1; hipLaunchKernelGGL(fwd_kernel, dim3(grid), dim3(NWAVES * 64), LDS_BYTES, stream, a); }
}
```

```cpp
#include <hip/hip_runtime.h>
#include <cstdio>
#include <cstdint>

#ifndef MK_N_LAUNCHES
#define MK_N_LAUNCHES 1
#endif

namespace pg8 {
#define PG8_LAS __attribute__((address_space(3)))
typedef unsigned short bf16_t;
typedef short bf16x8 __attribute__((ext_vector_type(8)));
typedef float f32x4 __attribute__((ext_vector_type(4)));
typedef unsigned u32x4 __attribute__((ext_vector_type(4)));
typedef unsigned u32x2 __attribute__((ext_vector_type(2)));
constexpr int BM = 256, BK = 64, HALF = 128, HTB = HALF * BK * 2, STAGE_BYTES = 8 * HTB, NXCD = 8, WGM = 8;

__host__ __device__ __forceinline__ int lds_byte(int r, int c) { const int st = (r >> 4) * 2 + (c >> 5), rr = r & 15, cc = c & 31, ob = rr * 64 + cc * 2; return st * 1024 + (ob ^ (((ob >> 9) & 1) << 5)); }
__host__ __device__ __forceinline__ void stage_rc(int b, int& R, int& C) { const int st = b / 1024, sb = b % 1024, swz = sb ^ (((sb >> 9) & 1) << 5); R = (st >> 1) * 16 + swz / 64; C = (st & 1) * 32 + (swz % 64) / 2; }
__host__ __device__ __forceinline__ int perm32(int rho) { const int n = rho >> 4, i = rho & 15; return 8 * (i >> 2) + 4 * n + (i & 3); }

struct Unit { int pm, pn; };
struct Gemm { const bf16_t* A; const bf16_t* Bt; int M, N, K; };

struct StaticOrder {
    int nM, nN, nwg, G, c;
    __host__ __device__ void init(int M, int N, int G_, int c_) { nM = M / BM; nN = N / BM; nwg = nM * nN; G = G_; c = c_; }
    __host__ __device__ bool next(int i, Unit& u) const {
        const long L = (long)i * G + c; if (L >= nwg) return false;
        int wgid = (int)L; { const int q = nwg / NXCD, r = nwg % NXCD, xcd = wgid % NXCD, off = wgid / NXCD; wgid = (xcd < r ? xcd * (q + 1) : r * (q + 1) + (xcd - r) * q) + off; }
        const int nig = WGM * nN, gid = wgid / nig, fm = gid * WGM, gsz = (nM - fm) < WGM ? (nM - fm) : WGM;
        u.pm = fm + ((wgid % nig) % gsz); u.pn = (wgid % nig) / gsz; return true;
    }
    __device__ __forceinline__ void a_ready(const Unit&) const {}
    __device__ __forceinline__ void done(const Unit&) const {}
};

__device__ __forceinline__ unsigned cvt_pk_bf16(float lo, float hi) { unsigned r; asm volatile("v_cvt_pk_bf16_f32 %0, %1, %2" : "=v"(r) : "v"(lo), "v"(hi)); return r; }

struct DynTailOrder : StaticOrder {
    unsigned* counter; volatile PG8_LAS unsigned* slot; int nstatic, ntail;
    __device__ __forceinline__ void init2(int M, int N, int G_, int c_, unsigned* counter_, volatile PG8_LAS unsigned* slot_) { init(M, N, G_, c_); counter = counter_; slot = slot_; nstatic = nwg / G; ntail = nwg % G; }
    __device__ __forceinline__ bool next(int i, Unit& u) const {
        if (i < nstatic) return StaticOrder::next(i, u);
        if (i > nstatic || ntail == 0) return false;
        if (threadIdx.x == 0) { const unsigned t = __hip_atomic_fetch_add(counter, 1u, __ATOMIC_RELAXED, __HIP_MEMORY_SCOPE_AGENT); *slot = t; }
        asm volatile("s_waitcnt lgkmcnt(0)" ::: "memory"); __builtin_amdgcn_s_barrier(); asm volatile("" ::: "memory");
        const unsigned t = *slot;
        if (t >= (unsigned)ntail) return false;
        StaticOrder T = *this; T.c = (int)t;
        return T.StaticOrder::next(nstatic, u);
    }
};

template <class Epi, class Sched, bool ALIGN_EPI = false, bool SP2 = false, bool AROWPERM = false, bool MIDSCALE = false>
__device__ __forceinline__ void gemm_phase(PG8_LAS unsigned char* lds, const Gemm g, const Sched& S, const Epi& E, const PG8_LAS float* midtab = nullptr, int midpm0 = 0) {
    const int tid = threadIdx.x, wid = __builtin_amdgcn_readfirstlane(tid >> 6), lane = tid & 63, wr = wid >> 2, wc = wid & 3, fr = lane & 15, fq = lane >> 4;
    const int K = g.K, nt = K / BK;
    unsigned voffA[2], voffB[2];
#pragma unroll
    for (int i = 0; i < 2; ++i) { int R, C; stage_rc(tid * 16 + i * 8192, R, C); const int Rb = Epi::PERM ? ((R & ~31) + perm32(R & 31)) : R;
        const int Ra = AROWPERM ? (128 * (R >> 6) + (R & 63)) : R;
        voffA[i] = (unsigned)(Ra * K + C) * 2u; voffB[i] = (unsigned)(Rb * K + C) * 2u; }
    const size_t kstep = (size_t)(BK * 2);
    const size_t hstepB = (size_t)HALF * K * 2;
    const size_t hstepA = AROWPERM ? (size_t)64 * K * 2 : (size_t)HALF * K * 2;
    const size_t tstep = (size_t)BM * K * 2;
    const unsigned ldsw = (unsigned)wid * 1024u;
    const int aoff = lds_byte(wr * 64 + fr, fq * 8), boff = lds_byte(wc * 32 + fr, fq * 8);
#define PG8_SA(b, h) (((b) * 2 + (h)) * HTB)
#define PG8_SB(b, h) ((4 + (b) * 2 + (h)) * HTB)
#define PG8_STAGE(bufoff, gbase, voff) do { _Pragma("unroll") for (int _i = 0; _i < 2; ++_i) \
        __builtin_amdgcn_global_load_lds((const unsigned*)((const char*)(gbase) + (voff)[_i]), (PG8_LAS unsigned*)(lds + (bufoff) + ldsw + _i * 8192), 16, 0, 0); } while (0)
#define PG8_LDA(dst, b, h) do { _Pragma("unroll") for (int m = 0; m < 4; ++m) _Pragma("unroll") for (int k = 0; k < 2; ++k) dst[m][k] = *(const PG8_LAS bf16x8*)(lds + PG8_SA(b, h) + aoff + m * 2048 + k * 1024); } while (0)
#define PG8_LDB(dst, b, h) do { _Pragma("unroll") for (int n = 0; n < 2; ++n) _Pragma("unroll") for (int k = 0; k < 2; ++k) dst[n][k] = *(const PG8_LAS bf16x8*)(lds + PG8_SB(b, h) + boff + n * 2048 + k * 1024); } while (0)
#define PG8_MMA(ai, bj, At, Bt) do { __builtin_amdgcn_s_setprio(1); _Pragma("unroll") for (int m = 0; m < 4; ++m) _Pragma("unroll") for (int n = 0; n < 2; ++n) _Pragma("unroll") for (int k = 0; k < 2; ++k) \
        acc[ai][bj][m][n] = __builtin_amdgcn_mfma_f32_16x16x32_bf16(Bt[n][k], At[m][k], acc[ai][bj][m][n], 0, 0, 0); __builtin_amdgcn_s_setprio(0); } while (0)
#define PG8_WAIT_V(n) asm volatile("s_waitcnt vmcnt(" #n ")" ::: "memory")
#define PG8_WAIT_L(n) asm volatile("s_waitcnt lgkmcnt(" #n ")" ::: "memory")
#define PG8_BAR __builtin_amdgcn_s_barrier()
#define PG8_SCHED __builtin_amdgcn_sched_barrier(0)
    Unit cur, nxt; int ui = 0;
    if (!S.next(0, cur)) return;
    f32x4 acc[2][2][4][2];
#pragma unroll
    for (int a = 0; a < 2; ++a)
#pragma unroll
        for (int b = 0; b < 2; ++b)
#pragma unroll
            for (int m = 0; m < 4; ++m)
#pragma unroll
                for (int n = 0; n < 2; ++n) acc[a][b][m][n] = (f32x4){0.f, 0.f, 0.f, 0.f};
    bf16x8 At[4][2], B0[2][2], B1[2][2];
    const char* cA = (const char*)g.A + (size_t)cur.pm * tstep; const char* cB = (const char*)g.Bt + (size_t)cur.pn * tstep;
    S.a_ready(cur);
    if constexpr (SP2) {
        PG8_STAGE(PG8_SB(0, 0), cB, voffB); PG8_STAGE(PG8_SB(0, 1), cB + hstepB, voffB); PG8_STAGE(PG8_SA(0, 0), cA, voffA); PG8_STAGE(PG8_SA(0, 1), cA + hstepA, voffA);
        if (wr == 1) PG8_BAR;
        PG8_WAIT_V(2); PG8_BAR;
        PG8_STAGE(PG8_SB(1, 0), cB + kstep, voffB); PG8_STAGE(PG8_SA(1, 0), cA + kstep, voffA); PG8_STAGE(PG8_SB(1, 1), cB + hstepB + kstep, voffB);
        PG8_WAIT_V(6); PG8_BAR;
    } else {
        PG8_STAGE(PG8_SB(0, 0), cB, voffB); PG8_STAGE(PG8_SA(0, 0), cA, voffA); PG8_STAGE(PG8_SB(0, 1), cB + hstepB, voffB); PG8_STAGE(PG8_SA(0, 1), cA + hstepA, voffA);
        if (wr == 1) PG8_BAR;
        PG8_WAIT_V(4); PG8_BAR;
        PG8_STAGE(PG8_SB(1, 0), cB + kstep, voffB); PG8_STAGE(PG8_SA(1, 0), cA + kstep, voffA); PG8_STAGE(PG8_SB(1, 1), cB + hstepB + kstep, voffB);
        PG8_WAIT_V(6); PG8_BAR;
    }
    for (;;) {
        const bool has_next = S.next(ui + 1, nxt);
        const char* nA = has_next ? (const char*)g.A + (size_t)nxt.pm * tstep : cA; const char* nB = has_next ? (const char*)g.Bt + (size_t)nxt.pn * tstep : cB;
        for (int t = 0; t < nt; t += 2) {
            const bool last = (t == nt - 2);
            const char* a1 = cA + (size_t)(t + 1) * kstep;
            const char* a2 = last ? nA : cA + (size_t)(t + 2) * kstep; const char* b2 = last ? nB : cB + (size_t)(t + 2) * kstep;
            const char* a3 = a2 + kstep; const char* b3 = b2 + kstep;
            if (last && has_next) S.a_ready(nxt);
            if constexpr (MIDSCALE) { if (t == nt / 2) {
#pragma unroll
                for (int a = 0; a < 2; ++a)
#pragma unroll
                    for (int m = 0; m < 4; ++m) { const float sc = midtab[(cur.pm - midpm0) * 256 + a * 128 + wr * 64 + m * 16 + fr];
#pragma unroll
                        for (int b = 0; b < 2; ++b)
#pragma unroll
                            for (int n = 0; n < 2; ++n) acc[a][b][m][n] = acc[a][b][m][n] * sc; } } }
            if constexpr (SP2) {
            PG8_LDB(B0, 0, 0); PG8_LDB(B1, 0, 1); PG8_SCHED; PG8_LDA(At, 0, 0); PG8_STAGE(PG8_SA(1, 1), a1 + hstepA, voffA);
            PG8_WAIT_V(8); PG8_WAIT_L(0); PG8_BAR; PG8_MMA(0, 0, At, B0); PG8_MMA(0, 1, At, B1); PG8_BAR; PG8_SCHED;
            PG8_LDA(At, 0, 1); PG8_STAGE(PG8_SB(0, 0), b2, voffB); PG8_STAGE(PG8_SB(0, 1), b2 + hstepB, voffB); PG8_STAGE(PG8_SA(0, 0), a2, voffA);
            PG8_WAIT_V(8); PG8_WAIT_L(0); PG8_BAR; PG8_MMA(1, 0, At, B0); PG8_MMA(1, 1, At, B1); PG8_BAR; PG8_SCHED;
            PG8_LDB(B0, 1, 0); PG8_LDB(B1, 1, 1); PG8_SCHED; PG8_LDA(At, 1, 0); PG8_STAGE(PG8_SA(0, 1), a2 + hstepA, voffA);
            PG8_WAIT_V(8); PG8_WAIT_L(0); PG8_BAR; PG8_MMA(0, 0, At, B0); PG8_MMA(0, 1, At, B1); PG8_BAR; PG8_SCHED;
            PG8_LDA(At, 1, 1); PG8_STAGE(PG8_SB(1, 0), b3, voffB); PG8_STAGE(PG8_SB(1, 1), b3 + hstepB, voffB); PG8_STAGE(PG8_SA(1, 0), a3, voffA);
            PG8_WAIT_V(8); PG8_WAIT_L(0); PG8_BAR; PG8_MMA(1, 0, At, B0); PG8_MMA(1, 1, At, B1); PG8_BAR; PG8_SCHED;
            } else {
            PG8_LDB(B0, 0, 0); PG8_SCHED; PG8_LDA(At, 0, 0); PG8_STAGE(PG8_SA(1, 1), a1 + hstepA, voffA);
            PG8_WAIT_L(8); PG8_BAR; PG8_WAIT_L(0); PG8_MMA(0, 0, At, B0); PG8_BAR; PG8_SCHED;
            PG8_LDB(B1, 0, 1); PG8_STAGE(PG8_SB(0, 0), b2, voffB);
            PG8_BAR; PG8_WAIT_L(0); PG8_MMA(0, 1, At, B1); PG8_BAR;
            PG8_LDA(At, 0, 1); PG8_STAGE(PG8_SA(0, 0), a2, voffA);
            PG8_BAR; PG8_WAIT_L(0); PG8_MMA(1, 0, At, B0); PG8_BAR; PG8_SCHED;
            PG8_STAGE(PG8_SB(0, 1), b2 + hstepB, voffB);
            PG8_WAIT_V(6); PG8_BAR; PG8_MMA(1, 1, At, B1); PG8_BAR;
            PG8_LDB(B0, 1, 0); PG8_SCHED; PG8_LDA(At, 1, 0); PG8_STAGE(PG8_SA(0, 1), a2 + hstepA, voffA);
            PG8_WAIT_L(8); PG8_BAR; PG8_WAIT_L(0); PG8_MMA(0, 0, At, B0); PG8_BAR; PG8_SCHED;
            PG8_LDB(B1, 1, 1); PG8_STAGE(PG8_SB(1, 0), b3, voffB);
            PG8_BAR; PG8_WAIT_L(0); PG8_MMA(0, 1, At, B1); PG8_BAR;
            PG8_LDA(At, 1, 1); PG8_STAGE(PG8_SA(1, 0), a3, voffA);
            PG8_BAR; PG8_WAIT_L(0); PG8_MMA(1, 0, At, B0); PG8_BAR; PG8_SCHED;
            PG8_STAGE(PG8_SB(1, 1), b3 + hstepB, voffB);
            PG8_WAIT_V(6); PG8_BAR; PG8_MMA(1, 1, At, B1); PG8_BAR;
            }
        }
        if constexpr (ALIGN_EPI) { if (wr == 0) PG8_BAR; }
        E(acc, cur, wr, wc, fr, fq); S.done(cur);
        if (!has_next) break;
#pragma unroll
        for (int a = 0; a < 2; ++a)
#pragma unroll
            for (int b = 0; b < 2; ++b)
#pragma unroll
                for (int m = 0; m < 4; ++m)
#pragma unroll
                    for (int n = 0; n < 2; ++n) acc[a][b][m][n] = (f32x4){0.f, 0.f, 0.f, 0.f};
        cur = nxt; cA = nA; cB = nB; ++ui;
        if constexpr (ALIGN_EPI) { if (wr == 1) PG8_BAR; }
    }
    PG8_WAIT_V(0);
    if constexpr (!ALIGN_EPI) { if (wr == 0) PG8_BAR; }
    PG8_BAR;
#undef PG8_SA
#undef PG8_SB
#undef PG8_STAGE
#undef PG8_LDA
#undef PG8_LDB
#undef PG8_MMA
#undef PG8_WAIT_V
#undef PG8_WAIT_L
#undef PG8_BAR
#undef PG8_SCHED
}
}

#ifndef PG8_SP2
#define PG8_SP2 true
#endif
#ifndef PG8_ALIGN
#define PG8_ALIGN true
#endif

constexpr int NWAVES = 8;
constexpr int BATCH = 8, SEQ = 2048, D = 4096, M = BATCH * SEQ;
constexpr int HGW = 2048, HD = 128, NH = 16, LRUW = 2048, NLB = 16, LBD = 128;
constexpr int NIN = 12288, DFF = 11008, NUP = 2 * DFF;
constexpr float EPS = 1e-6f;
constexpr int NSTRIP = M / 128;

constexpr size_t MiB = 1u << 20;
constexpr size_t WS_CTL = 0, CTL_ZERO_BYTES = 1 * MiB;
constexpr size_t WS_WIN = 1 * MiB;
constexpr size_t WS_WOUT = WS_WIN + (size_t)NIN * D * 2;
constexpr size_t WS_WUP = WS_WOUT + (size_t)D * D * 2;
constexpr size_t WS_WDN = WS_WUP + (size_t)NUP * D * 2;
constexpr size_t WS_XN = WS_WDN + (size_t)D * DFF * 2;
constexpr size_t WS_PROJ = WS_XN + (size_t)M * D * 2;
constexpr size_t WS_ACT = WS_PROJ;
constexpr size_t WS_MIX = WS_PROJ + (size_t)M * NIN * 2;
constexpr size_t WS_SIDE = WS_MIX + (size_t)M * D * 2;
constexpr size_t WS_SSQL = WS_SIDE + (size_t)NSTRIP * 4 * NUP * 4;
constexpr size_t WS_SSQ2 = WS_SSQL + (size_t)16 * M * 4;
constexpr size_t WS_RSTG = WS_SSQ2 + (size_t)M * 64 * 4;
constexpr size_t WS_END = WS_RSTG + (size_t)M * 4;
constexpr int CW_TMO = 0, CW_CODE = 1, CW_BAR = 4096;

constexpr int RING_OFF = 0, RING_BYTES = 131072;
constexpr int LDSCTL_OFF = 143360, MISC_OFF = LDSCTL_OFF + 320;
constexpr int LDS_BYTES = 147456;

#define GAS __attribute__((address_space(1)))
#define LAS __attribute__((address_space(3)))
typedef unsigned short bf16;
typedef unsigned v4u __attribute__((ext_vector_type(4)));
typedef unsigned v2u __attribute__((ext_vector_type(2)));
typedef float f32x4 __attribute__((ext_vector_type(4)));
typedef float f32x2 __attribute__((ext_vector_type(2)));
typedef GAS unsigned gu32;
#define RLX_AGENT __ATOMIC_RELAXED, __HIP_MEMORY_SCOPE_AGENT
#define LDS_WAIT() asm volatile("s_waitcnt lgkmcnt(0)" ::: "memory")
#define VM_WAIT() asm volatile("s_waitcnt vmcnt(0)" ::: "memory")
__device__ __forceinline__ unsigned f2bf(float f) { unsigned u = __builtin_bit_cast(unsigned, f); return (u + 0x7fffu + ((u >> 16) & 1u)) >> 16; }
__device__ __forceinline__ unsigned pk2(float lo, float hi) { return f2bf(lo) | (f2bf(hi) << 16); }
typedef __bf16 bf16x2_t __attribute__((ext_vector_type(2)));
__device__ __forceinline__ unsigned cvtpk(float lo, float hi) { const f32x2 v = {lo, hi}; const bf16x2_t b = __builtin_convertvector(v, bf16x2_t); return __builtin_bit_cast(unsigned, b); }
__device__ __forceinline__ float bf_lo(unsigned u) { return __builtin_bit_cast(float, u << 16); }
__device__ __forceinline__ float bf_hi(unsigned u) { return __builtin_bit_cast(float, u & 0xffff0000u); }
__device__ __forceinline__ float fexp(float x) { return __builtin_amdgcn_exp2f(x * 1.44269504089f); }
__device__ __forceinline__ float sigmoidf_(float x) { return __builtin_amdgcn_rcpf(1.0f + fexp(-x)); }
__device__ __forceinline__ float siluf_(float x) { return x * sigmoidf_(x); }
__device__ __forceinline__ float gelu_tanh_(float y) { const float z = 0.7978845608028654f * (y + 0.044715f * y * y * y); return y * sigmoidf_(2.0f * z); }

#define XB_TMO      128
#define XB_XCNT(j)  (256  + 64 * (j))
#define XB_XSUB(j)  (1280 + 64 * (j))
#define XB_XGEN(j)  (2304 + 64 * (j))
#define XB_TOP      3328
#define XB_TOPGEN   3392
#define XCD_BAR_WORDS 3456
#define XB_SPIN_CAP (1u << 18)
__device__ __forceinline__ unsigned xb_ld(unsigned* p)              { return __hip_atomic_load(p, __ATOMIC_RELAXED, __HIP_MEMORY_SCOPE_AGENT); }
__device__ __forceinline__ unsigned xb_add(unsigned* p, unsigned v) { return __hip_atomic_fetch_add(p, v, __ATOMIC_RELAXED, __HIP_MEMORY_SCOPE_AGENT); }
__device__ __forceinline__ unsigned xb_xcc_id() { return (unsigned)__builtin_amdgcn_s_getreg((3 << 11) | 20) & 0xFu; }
#define XB_SPIN(cond, bar) do { unsigned _sp = 0; while (cond) { __builtin_amdgcn_s_sleep(1); \
    if ((++_sp & 255u) == 0u) { if (xb_ld(&(bar)[XB_TMO])) break; if (_sp > XB_SPIN_CAP) { atomicAdd(&(bar)[XB_TMO], 1u); break; } } } } while (0)
struct XcdBarrier { unsigned* bar; unsigned x; volatile LAS unsigned* st; };
__device__ __forceinline__ XcdBarrier xcd_barrier_post(unsigned* bar, volatile LAS unsigned* st) {
    XcdBarrier b; b.bar = bar; b.x = xb_xcc_id(); b.st = st;
    if (threadIdx.x == 0) (void)xb_add(&bar[XB_XCNT(b.x)], 1u);
    return b;
}
__device__ __forceinline__ void xcd_barrier_complete(unsigned* bar, unsigned x, unsigned& nloc, unsigned& nx) {
    const unsigned G = gridDim.x * gridDim.y * gridDim.z;
    unsigned sum, cnt, mine, sp = 0u;
    for (;;) {
        sum = 0u; cnt = 0u; mine = 0u;
#pragma unroll
        for (unsigned j = 0; j < 16; ++j) { const unsigned c = xb_ld(&bar[XB_XCNT(j)]); sum += c; cnt += (c > 0u) ? 1u : 0u; mine = (j == x) ? c : mine; }
        if (sum == G) break;
        __builtin_amdgcn_s_sleep(1);
        if ((++sp & 255u) == 0u) { if (xb_ld(&bar[XB_TMO])) break; if (sp > XB_SPIN_CAP) { atomicAdd(&bar[XB_TMO], 1u); break; } }
    }
    nloc = mine > 0u ? mine : 1u; nx = cnt > 0u ? cnt : 1u;
}
__device__ __forceinline__ void xcd_barrier(const XcdBarrier& b) {
    asm volatile("s_waitcnt vmcnt(0)" ::: "memory");
    __syncthreads();
    if (threadIdx.x == 0) {
        unsigned* bar = b.bar;
        __builtin_amdgcn_s_waitcnt(0);
        unsigned nloc = b.st[0], nx = b.st[1];
        if (nloc == 0u) { xcd_barrier_complete(bar, b.x, nloc, nx); b.st[0] = nloc; b.st[1] = nx; }
        const unsigned old = xb_add(&bar[XB_XSUB(b.x)], 1u);
        const unsigned gen = old / nloc;
        if (old + 1u == (gen + 1u) * nloc) {
            __builtin_amdgcn_fence(__ATOMIC_RELEASE, "agent");
            asm volatile("s_waitcnt vmcnt(0)" ::: "memory");
            const unsigned og = xb_add(&bar[XB_TOP], 1u);
            const unsigned tg = og / nx;
            if (og + 1u == (tg + 1u) * nx) xb_add(&bar[XB_TOPGEN], 1u);
            else XB_SPIN(xb_ld(&bar[XB_TOPGEN]) == tg, bar);
            __builtin_amdgcn_fence(__ATOMIC_ACQUIRE, "agent");
            xb_add(&bar[XB_XGEN(b.x)], 1u);
            asm volatile("s_waitcnt vmcnt(0)" ::: "memory");
        } else {
            XB_SPIN(xb_ld(&bar[XB_XGEN(b.x)]) == gen, bar);
            __builtin_amdgcn_fence(__ATOMIC_ACQUIRE, "agent");
            asm volatile("s_waitcnt vmcnt(0)" ::: "memory");
        }
    }
    __syncthreads();
}

struct Frame {
    LAS unsigned char* lds;
    volatile LAS unsigned* MISC;
    gu32* ctl;
    int tid, lane, wave;
    int vcu, G;
    const float* x; float* out;
    const float *ln1_w, *w_in, *lb_gamma, *hg_norm_w, *lru_conv_w, *lru_conv_b, *lru_wa, *lru_ba, *lru_wx, *lru_bx, *lru_lambda, *lru_norm_w, *w_out, *ln2_w, *w_up, *ffn_conv_w, *ffn_conv_b, *w_down, *final_norm_w;
    bf16 *Win_t, *Wout_t, *Wup_t, *Wdn_t;
    bf16 *XN, *PROJ, *MIX, *ACT;
    float *SIDE, *SSQL, *SSQ2, *RSTG;
};

__device__ __forceinline__ float wave_sum(float v) {
#pragma unroll
    for (int o = 1; o < 64; o <<= 1) v += __shfl_xor(v, o);
    return v;
}

__device__ __forceinline__ void p0_transpose_item(const float* W, int N, bf16* WT, int ldt, int dst_row, int k0, int n0, LAS float* scr, int lane, const float* kscale = nullptr, int kdst = -1) {
    if (kdst < 0) kdst = k0;
#pragma unroll 8
    for (int i = 0; i < 32; ++i) { const int kk = 2 * i + (lane >> 5); scr[kk * 33 + (lane & 31)] = __builtin_nontemporal_load(&W[(size_t)(k0 + kk) * N + n0 + (lane & 31)]); }
    LDS_WAIT(); asm volatile("" ::: "memory");
    const int c = lane & 7;
    f32x4 sc0 = (f32x4){1.f, 1.f, 1.f, 1.f}, sc1 = sc0;
    if (kscale) { sc0 = *(const GAS f32x4*)(kscale + k0 + 8 * c); sc1 = *(const GAS f32x4*)(kscale + k0 + 8 * c + 4); }
#pragma unroll
    for (int j = 0; j < 4; ++j) { const int n = (lane >> 3) + 8 * j; const LAS float* s = scr + (8 * c) * 33 + n;
        v4u o; o.x = cvtpk(s[0 * 33] * sc0.x, s[1 * 33] * sc0.y); o.y = cvtpk(s[2 * 33] * sc0.z, s[3 * 33] * sc0.w); o.z = cvtpk(s[4 * 33] * sc1.x, s[5 * 33] * sc1.y); o.w = cvtpk(s[6 * 33] * sc1.z, s[7 * 33] * sc1.w);
        *(GAS v4u*)(WT + (size_t)(dst_row + n) * ldt + kdst + 8 * c) = o; }
    LDS_WAIT(); asm volatile("" ::: "memory");
}
__device__ __forceinline__ void rms_row_to_bf16(int lane, const float* xrow, const float* w, bf16* orow) {
    const GAS f32x4* xr = (const GAS f32x4*)xrow + lane;
    f32x4 v[16]; float s = 0.f;
#pragma unroll
    for (int j = 0; j < 16; ++j) { v[j] = __builtin_nontemporal_load(&xr[64 * j]); s += (v[j].x * v[j].x + v[j].y * v[j].y) + (v[j].z * v[j].z + v[j].w * v[j].w); }
    const float rstd = __builtin_amdgcn_rsqf(wave_sum(s) * (1.f / D) + EPS);
    GAS unsigned long long* o8 = (GAS unsigned long long*)orow + lane;
    const GAS f32x4* wr = (const GAS f32x4*)w + lane;
#pragma unroll
    for (int j = 0; j < 16; ++j) { const f32x4 g = wr[64 * j]; o8[64 * j] = (unsigned long long)pk2(v[j].x * rstd * g.x, v[j].y * rstd * g.y) | ((unsigned long long)pk2(v[j].z * rstd * g.z, v[j].w * rstd * g.w) << 32); }
}
__device__ __forceinline__ void rms_row_bf16_to_f32(int lane, const bf16* hrow, const float* w, float* orow) {
    const GAS v2u* hr = (const GAS v2u*)hrow + lane;
    v2u v[16]; float s = 0.f;
#pragma unroll
    for (int j = 0; j < 16; ++j) { v[j] = hr[64 * j]; const float a0 = bf_lo(v[j].x), a1 = bf_hi(v[j].x), a2 = bf_lo(v[j].y), a3 = bf_hi(v[j].y); s += (a0 * a0 + a1 * a1) + (a2 * a2 + a3 * a3); }
    const float rstd = __builtin_amdgcn_rsqf(wave_sum(s) * (1.f / D) + EPS);
    GAS f32x4* o = (GAS f32x4*)orow + lane;
    const GAS f32x4* wr = (const GAS f32x4*)w + lane;
#pragma unroll
    for (int j = 0; j < 16; ++j) { const f32x4 g = wr[64 * j]; __builtin_nontemporal_store((f32x4){bf_lo(v[j].x) * rstd * g.x, bf_hi(v[j].x) * rstd * g.y, bf_lo(v[j].y) * rstd * g.z, bf_hi(v[j].y) * rstd * g.w}, &o[64 * j]); }
}
template <int WHICH> __device__ __forceinline__ void p_convert_w(Frame& F) {
    LAS float* scr = (LAS float*)(F.lds + RING_OFF + F.wave * 16384);
    const int gw = F.vcu * NWAVES + F.wave, NGW = F.G * NWAVES;
    constexpr int I_IN = (D / 64) * (NIN / 32), I_OUT = (D / 64) * (D / 32), I_UP = (D / 64) * (NUP / 32);
    constexpr int NITEMS = WHICH == 0 ? I_IN : WHICH == 1 ? I_OUT : I_UP;
    for (int r = gw; r < NITEMS; r += NGW) {
        if constexpr (WHICH == 0) { const int nblk = NIN / 32, kb = r / nblk, nb = r % nblk; p0_transpose_item(F.w_in, NIN, F.Win_t, D, 32 * nb, 64 * kb, 32 * nb, scr, F.lane); }
        else if constexpr (WHICH == 1) { const int nblk = D / 32, kb = r / nblk, nb = r % nblk; const int k0 = 64 * kb;
            p0_transpose_item(F.w_out, D, F.Wout_t, D, 32 * nb, k0, 32 * nb, scr, F.lane, k0 >= HGW ? F.lru_norm_w - HGW : nullptr, k0 ^ HGW); }
        else { const int nblk = NUP / 32, kb = r / nblk, nb = r % nblk; int n0 = 32 * nb; const int isval = n0 >= DFF ? 1 : 0; const int c = n0 - isval * DFF;
            const int drow = 256 * (c >> 7) + 128 * isval + (c & 127);
            p0_transpose_item(F.w_up, NUP, F.Wup_t, D, drow, 64 * kb, n0, scr, F.lane, F.ln2_w); }
    }
}
__device__ __forceinline__ void p0_prologue(Frame& F) {
    const int gw = F.vcu * NWAVES + F.wave, NGW = F.G * NWAVES;
    p_convert_w<0>(F);
    for (int m = gw; m < M; m += NGW) rms_row_to_bf16(F.lane, F.x + (size_t)m * D, F.ln1_w, F.XN + (size_t)m * D);
}
__device__ __forceinline__ void p_convert_wdown(Frame& F, int rank, int nw) {
    LAS float* scr = (LAS float*)(F.lds + RING_OFF + F.wave * 16384);
    constexpr int I_DN = (DFF / 64) * (D / 32);
    for (int it = rank * NWAVES + F.wave; it < I_DN; it += nw * NWAVES) { const int nblk = D / 32, kb = it / nblk, nb = it % nblk;
        p0_transpose_item(F.w_down, D, F.Wdn_t, DFF, 32 * nb, 64 * kb, 32 * nb, scr, F.lane); }
}
struct EpiProj {
    static constexpr bool PERM = true;
    bf16* O; const float* lb_gamma;
    __device__ __forceinline__ void operator()(const pg8::f32x4 (&acc)[2][2][4][2], const pg8::Unit& u, int wr, int wc, int fr, int fq) const {
        const int row0 = u.pm * 256 + wr * 64 + fr, col0 = u.pn * 256 + wc * 32 + 8 * fq;
        const int grp = u.pn >> 3;
        float oml[2][8];
        if (grp == 1) {
#pragma unroll
            for (int bj = 0; bj < 2; ++bj)
#pragma unroll
                for (int j = 0; j < 8; ++j) { const int c = col0 + bj * 128 + j - HGW; oml[bj][j] = __builtin_amdgcn_rcpf(1.0f + fexp(lb_gamma[c] - lb_gamma[HGW + c])); }
        } else {
#pragma unroll
            for (int bj = 0; bj < 2; ++bj)
#pragma unroll
                for (int j = 0; j < 8; ++j) oml[bj][j] = 0.f;
        }
#pragma unroll
        for (int ai = 0; ai < 2; ++ai)
#pragma unroll
            for (int m = 0; m < 4; ++m) { bf16* rowp = O + (size_t)(row0 + ai * 128 + m * 16) * NIN + col0;
#pragma unroll
                for (int bj = 0; bj < 2; ++bj) { float v[8];
#pragma unroll
                    for (int j = 0; j < 8; ++j) v[j] = acc[ai][bj][m][j >> 2][j & 3];
                    if (grp == 0 || grp == 3) {
#pragma unroll
                        for (int j = 0; j < 8; ++j) v[j] = siluf_(v[j]);
                    } else if (grp == 1) {
#pragma unroll
                        for (int j = 0; j < 8; ++j) v[j] = oml[bj][j] * __builtin_amdgcn_rcpf(1.0f + fexp(v[j]));
                    } else if (grp == 5) {
#pragma unroll
                        for (int j = 0; j < 8; ++j) v[j] = gelu_tanh_(v[j]);
                    }
                    pg8::u32x4 w; w.x = pg8::cvt_pk_bf16(v[0], v[1]); w.y = pg8::cvt_pk_bf16(v[2], v[3]); w.z = pg8::cvt_pk_bf16(v[4], v[5]); w.w = pg8::cvt_pk_bf16(v[6], v[7]);
                    *(pg8::u32x4*)(rowp + bj * 128) = w; } }
    }
};
struct EpiRes2 {
    static constexpr bool PERM = true;
    const float* x; bf16* H; float* ssq;
    __device__ __forceinline__ void operator()(const pg8::f32x4 (&acc)[2][2][4][2], const pg8::Unit& u, int wr, int wc, int fr, int fq) const {
        const int row0 = u.pm * 256 + wr * 64 + fr, col0 = u.pn * 256 + wc * 32 + 8 * fq;
#pragma unroll
        for (int ai = 0; ai < 2; ++ai) {
            pg8::f32x4 r[4][2][2];
#pragma unroll
            for (int m = 0; m < 4; ++m) { const size_t off = (size_t)(row0 + ai * 128 + m * 16) * D + col0;
#pragma unroll
                for (int bj = 0; bj < 2; ++bj) { r[m][bj][0] = *(const pg8::f32x4*)(x + off + bj * 128); r[m][bj][1] = *(const pg8::f32x4*)(x + off + bj * 128 + 4); } }
#pragma unroll
            for (int m = 0; m < 4; ++m) { const int row = row0 + ai * 128 + m * 16; const size_t off = (size_t)row * D + col0; float ss = 0.f;
#pragma unroll
                for (int bj = 0; bj < 2; ++bj) { const pg8::f32x4 v0 = r[m][bj][0] + acc[ai][bj][m][0], v1 = r[m][bj][1] + acc[ai][bj][m][1];
                    ss += ((v0[0] * v0[0] + v0[1] * v0[1]) + (v0[2] * v0[2] + v0[3] * v0[3])) + ((v1[0] * v1[0] + v1[1] * v1[1]) + (v1[2] * v1[2] + v1[3] * v1[3]));
                    pg8::u32x4 w; w.x = pg8::cvt_pk_bf16(v0[0], v0[1]); w.y = pg8::cvt_pk_bf16(v0[2], v0[3]); w.z = pg8::cvt_pk_bf16(v1[0], v1[1]); w.w = pg8::cvt_pk_bf16(v1[2], v1[3]);
                    *(pg8::u32x4*)(H + off + bj * 128) = w; }
                ss += __shfl_xor(ss, 16); ss += __shfl_xor(ss, 32);
                if (fq == 0) ssq[(size_t)row * 64 + u.pn * 4 + wc] = ss; }
            asm volatile("" ::: "memory");
        }
    }
};
struct EpiRes4 {
    static constexpr bool PERM = true;
    bf16* H;
    __device__ __forceinline__ void operator()(const pg8::f32x4 (&acc)[2][2][4][2], const pg8::Unit& u, int wr, int wc, int fr, int fq) const {
        const int row0 = u.pm * 256 + wr * 64 + fr, col0 = u.pn * 256 + wc * 32 + 8 * fq;
#pragma unroll
        for (int ai = 0; ai < 2; ++ai) {
            pg8::u32x4 r[4][2];
#pragma unroll
            for (int m = 0; m < 4; ++m) { const size_t off = (size_t)(row0 + ai * 128 + m * 16) * D + col0;
#pragma unroll
                for (int bj = 0; bj < 2; ++bj) r[m][bj] = *(const pg8::u32x4*)(H + off + bj * 128); }
#pragma unroll
            for (int m = 0; m < 4; ++m) { const size_t off = (size_t)(row0 + ai * 128 + m * 16) * D + col0;
#pragma unroll
                for (int bj = 0; bj < 2; ++bj) { const pg8::u32x4 h = r[m][bj]; const pg8::f32x4 a0 = acc[ai][bj][m][0], a1 = acc[ai][bj][m][1];
                    pg8::u32x4 w; w.x = pg8::cvt_pk_bf16(bf_lo(h.x) + a0[0], bf_hi(h.x) + a0[1]); w.y = pg8::cvt_pk_bf16(bf_lo(h.y) + a0[2], bf_hi(h.y) + a0[3]);
                    w.z = pg8::cvt_pk_bf16(bf_lo(h.z) + a1[0], bf_hi(h.z) + a1[1]); w.w = pg8::cvt_pk_bf16(bf_lo(h.w) + a1[2], bf_hi(h.w) + a1[3]);
                    *(pg8::u32x4*)(H + off + bj * 128) = w; } }
            asm volatile("" ::: "memory");
        }
    }
};
template <int CTRL> __device__ __forceinline__ float dppf(float v) { return __builtin_bit_cast(float, __builtin_amdgcn_update_dpp(0, __builtin_bit_cast(int, v), CTRL, 0xf, 0xf, true)); }
template <int CTRL> __device__ __forceinline__ float dppr(float v) { return __builtin_bit_cast(float, __builtin_amdgcn_mov_dpp(__builtin_bit_cast(int, v), CTRL, 0xf, 0xf, false)); }
struct EpiUp {
    static constexpr bool PERM = true;
    bf16* ACT; float* SIDE; const float* cw; const float* cb; const LAS float* rst; int pm0; const float* rstg;
    __device__ __forceinline__ void operator()(const pg8::f32x4 (&acc)[2][2][4][2], const pg8::Unit& u, int wr, int wc, int fr, int fq) const {
        const int strip = u.pm * 2 + wr;
        const int gc0 = u.pn * 128 + wc * 32 + 8 * fq;
        float* side = SIDE + (size_t)strip * 4 * NUP;
        const bool l15 = (fr == 15), l14 = (fr >= 14);
        float rs[8];
#pragma unroll
        for (int g = 0; g < 8; ++g) rs[g] = ((unsigned)(u.pm - pm0) < 8u) ? rst[(u.pm - pm0) * 256 + wr * 128 + g * 16 + fr] : __hip_atomic_load(rstg + u.pm * 256 + wr * 128 + g * 16 + fr, __ATOMIC_RELAXED, __HIP_MEMORY_SCOPE_AGENT);
        unsigned pk[8][2];
#pragma unroll
        for (int n = 0; n < 2; ++n) {
            const int gc = gc0 + 4 * n;
            const pg8::f32x4 wg0 = *(const pg8::f32x4*)(cw + gc), wg1 = *(const pg8::f32x4*)(cw + NUP + gc), wg2 = *(const pg8::f32x4*)(cw + 2 * NUP + gc), bg = *(const pg8::f32x4*)(cb + gc);
            const pg8::f32x4 wv0 = *(const pg8::f32x4*)(cw + DFF + gc), wv1 = *(const pg8::f32x4*)(cw + NUP + DFF + gc), wv2 = *(const pg8::f32x4*)(cw + 2 * NUP + DFF + gc), bv = *(const pg8::f32x4*)(cb + DFF + gc);
            pg8::f32x4 PG = (pg8::f32x4){0.f, 0.f, 0.f, 0.f}, PV = PG;
#pragma unroll
            for (int g = 0; g < 8; ++g) {
                const pg8::f32x4 Gv = acc[g >> 2][0][g & 3][n] * rs[g], Vv = acc[g >> 2][1][g & 3][n] * rs[g];
                if (g == 0 && fr < 2) { *(pg8::f32x4*)(side + (size_t)fr * NUP + gc) = Gv; *(pg8::f32x4*)(side + (size_t)fr * NUP + DFF + gc) = Vv; }
                if (g == 7 && fr >= 14) { *(pg8::f32x4*)(side + (size_t)(fr - 12) * NUP + gc) = Gv; *(pg8::f32x4*)(side + (size_t)(fr - 12) * NUP + DFF + gc) = Vv; }
                float o[4];
#pragma unroll
                for (int j = 0; j < 4; ++j) {
                    const float g1 = dppr<0x121>(l15 ? PG[j] : Gv[j]), g2 = dppr<0x122>(l14 ? PG[j] : Gv[j]);
                    const float v1 = dppr<0x121>(l15 ? PV[j] : Vv[j]), v2 = dppr<0x122>(l14 ? PV[j] : Vv[j]);
                    const float cg = bg[j] + wg2[j] * Gv[j] + wg1[j] * g1 + wg0[j] * g2;
                    const float cv = bv[j] + wv2[j] * Vv[j] + wv1[j] * v1 + wv0[j] * v2;
                    o[j] = siluf_(cg) * cv;
                }
                pk[g][0] = (n == 0) ? pg8::cvt_pk_bf16(o[0], o[1]) : pk[g][0]; pk[g][1] = (n == 0) ? pg8::cvt_pk_bf16(o[2], o[3]) : pk[g][1];
                if (n == 1) { pg8::u32x4 w; w.x = pk[g][0]; w.y = pk[g][1]; w.z = pg8::cvt_pk_bf16(o[0], o[1]); w.w = pg8::cvt_pk_bf16(o[2], o[3]);
                    *(pg8::u32x4*)(ACT + (size_t)(strip * 128 + g * 16 + fr) * DFF + gc0) = w; }
                PG = Gv; PV = Vv;
            }
        }
    }
};

#define LBAR() do { asm volatile("s_waitcnt lgkmcnt(0)" ::: "memory"); __builtin_amdgcn_s_barrier(); asm volatile("" ::: "memory"); } while (0)
typedef short bf16x8_t __attribute__((ext_vector_type(8)));
__device__ __forceinline__ float row16_sum(float v) {
    v += __builtin_bit_cast(float, __builtin_amdgcn_update_dpp(0, __builtin_bit_cast(int, v), 0x128, 0xf, 0xf, false));
    v += __builtin_bit_cast(float, __builtin_amdgcn_update_dpp(0, __builtin_bit_cast(int, v), 0x124, 0xf, 0xf, false));
    v += __builtin_bit_cast(float, __builtin_amdgcn_update_dpp(0, __builtin_bit_cast(int, v), 0x122, 0xf, 0xf, false));
    v += __builtin_bit_cast(float, __builtin_amdgcn_update_dpp(0, __builtin_bit_cast(int, v), 0x121, 0xf, 0xf, false));
    return v;
}
__device__ __forceinline__ void hgrn_unit(Frame& F, int b, int h) {
    constexpr int QS = 0, KS = 16384, GS = 32768, KT = 49152, VT = 67584, TS = 144, PS = 86016, OS = 95232, OSS = 528, SEGS = 129024, DEC = 133120;
    LAS unsigned char* L = F.lds;
    const int tid = F.tid, lane = F.lane, w = F.wave, quad = lane >> 4, l16 = lane & 15;
    const int vrow = 16 * w + l16;
    f32x4 Sacc[8];
#pragma unroll
    for (int kt = 0; kt < 8; ++kt) Sacc[kt] = (f32x4){0.f, 0.f, 0.f, 0.f};
    for (int i = tid; i < 9216 / 4; i += 512) ((LAS unsigned*)(L + PS))[i] = 0u;
    const int t_o = tid >> 3, part = tid & 7;
    f32x4 nw[4];
#pragma unroll
    for (int i = 0; i < 4; ++i) nw[i] = *(const GAS f32x4*)(F.hg_norm_w + h * HD + 16 * part + 4 * i);
    const bf16* src = F.PROJ + (size_t)(b * SEQ) * NIN + h * HD;
    v4u pre[2][4];
#pragma unroll
    for (int it = 0; it < 2; ++it) { const int p = tid + 512 * it, row = p >> 4, c = p & 15;
#pragma unroll
        for (int a = 0; a < 4; ++a) pre[it][a] = *(const GAS v4u*)(src + (size_t)row * NIN + a * HGW + c * 8); }
    const int cbase = (((lane >> 2) ^ (8 * (w & 1))) << 4), boff = (lane & 3) * 4;
    for (int ch = 0; ch < SEQ / 64; ++ch) {
        const int t0 = 64 * ch;
#pragma unroll
        for (int it = 0; it < 2; ++it) { const int p = tid + 512 * it, row = p >> 4, c = p & 15; const int sw = (c ^ (row & 15)) * 16;
            *(LAS v4u*)(L + QS + row * 256 + sw) = pre[it][0]; *(LAS v4u*)(L + KS + row * 256 + sw) = pre[it][1]; *(LAS v4u*)(L + GS + row * 256 + c * 16) = pre[it][3];
            const v4u vv = pre[it][2]; LAS unsigned short* vt = (LAS unsigned short*)(L + VT + (8 * c) * TS + row * 2);
            vt[0 * (TS / 2)] = (unsigned short)(vv.x & 0xffffu); vt[1 * (TS / 2)] = (unsigned short)(vv.x >> 16); vt[2 * (TS / 2)] = (unsigned short)(vv.y & 0xffffu); vt[3 * (TS / 2)] = (unsigned short)(vv.y >> 16);
            vt[4 * (TS / 2)] = (unsigned short)(vv.z & 0xffffu); vt[5 * (TS / 2)] = (unsigned short)(vv.z >> 16); vt[6 * (TS / 2)] = (unsigned short)(vv.w & 0xffffu); vt[7 * (TS / 2)] = (unsigned short)(vv.w >> 16); }
        LBAR();
        if (ch + 1 < SEQ / 64) {
#pragma unroll
            for (int it = 0; it < 2; ++it) { const int p = tid + 512 * it, row = p >> 4, c = p & 15;
#pragma unroll
                for (int a = 0; a < 4; ++a) pre[it][a] = *(const GAS v4u*)(src + (size_t)(t0 + 64 + row) * NIN + a * HGW + c * 8); } }
        { float k0[8], k1[8], P0[8], P1[8]; float r0 = 1.f, r1 = 1.f;
#pragma unroll
          for (int i = 0; i < 8; ++i) { const unsigned kk = *(const LAS unsigned*)(L + KS + (8 * w + i) * 256 + (cbase ^ (i << 4)) + boff);
              k0[i] = bf_lo(kk); k1[i] = bf_hi(kk); r0 *= (1.0f - k0[i]); r1 *= (1.0f - k1[i]); P0[i] = r0; P1[i] = r1; }
          *(LAS f32x2*)(L + SEGS + (w * 128 + 2 * lane) * 4) = (f32x2){r0, r1};
          LBAR();
          float b0 = 1.f, b1 = 1.f, tt0 = 1.f, tt1 = 1.f;
#pragma unroll
          for (int w2 = 0; w2 < 8; ++w2) { const f32x2 sg = *(const LAS f32x2*)(L + SEGS + (w2 * 128 + 2 * lane) * 4); tt0 *= sg.x; tt1 *= sg.y; if (w2 < w) { b0 *= sg.x; b1 *= sg.y; } }
          unsigned kh0[4], kh1[4];
#pragma unroll
          for (int i = 0; i < 8; i += 2) { float hv0[2], hv1[2];
#pragma unroll
              for (int u = 0; u < 2; ++u) { const int ii = i + u; const int ad = (8 * w + ii) * 256 + (cbase ^ (ii << 4)) + boff;
                  const float e0 = b0 * P0[ii], e1 = b1 * P1[ii];
                  const float i0 = __builtin_amdgcn_rcpf(fmaxf(e0, 1e-35f)), i1 = __builtin_amdgcn_rcpf(fmaxf(e1, 1e-35f));
                  const unsigned qq = *(const LAS unsigned*)(L + QS + ad);
                  *(LAS unsigned*)(L + QS + ad) = cvtpk(bf_lo(qq) * e0, bf_hi(qq) * e1);
                  const float kt0 = k0[ii] * i0, kt1 = k1[ii] * i1;
                  *(LAS unsigned*)(L + KS + ad) = cvtpk(kt0, kt1);
                  hv0[u] = kt0 * tt0; hv1[u] = kt1 * tt1; }
              kh0[i >> 1] = cvtpk(hv0[0], hv0[1]); kh1[i >> 1] = cvtpk(hv1[0], hv1[1]); }
          *(LAS v4u*)(L + KT + (2 * lane) * TS + 16 * w) = (v4u){kh0[0], kh0[1], kh0[2], kh0[3]};
          *(LAS v4u*)(L + KT + (2 * lane + 1) * TS + 16 * w) = (v4u){kh1[0], kh1[1], kh1[2], kh1[3]};
          if (w == 0) *(LAS f32x2*)(L + DEC + (2 * lane) * 4) = (f32x2){tt0, tt1}; }
        LBAR();
#pragma unroll
        for (int rep = 0; rep < 2; ++rep) { const int idx = w + 8 * rep;
            if (idx < 10) { const int ti = (idx >= 6) ? 3 : (idx >= 3) ? 2 : (idx >= 1) ? 1 : 0, si = idx - ((ti * (ti + 1)) >> 1);
                f32x4 acc = (f32x4){0.f, 0.f, 0.f, 0.f};
#pragma unroll
                for (int ks = 0; ks < 4; ++ks) { const int rk = 16 * si + l16, rq = 16 * ti + l16;
                    const bf16x8_t Ak = *(const LAS bf16x8_t*)(L + KS + rk * 256 + (((4 * ks + quad) ^ (rk & 15)) * 16));
                    const bf16x8_t Bq = *(const LAS bf16x8_t*)(L + QS + rq * 256 + (((4 * ks + quad) ^ (rq & 15)) * 16));
                    acc = __builtin_amdgcn_mfma_f32_16x16x32_bf16(Ak, Bq, acc, 0, 0, 0); }
                if (si == ti) {
#pragma unroll
                    for (int j = 0; j < 4; ++j) acc[j] = (4 * quad + j > l16) ? 0.f : acc[j]; }
                *(LAS v2u*)(L + PS + (16 * ti + l16) * TS + (16 * si + 4 * quad) * 2) = (v2u){cvtpk(acc[0], acc[1]), cvtpk(acc[2], acc[3])}; } }
        f32x4 O[4];
        { unsigned Sb[8][2];
#pragma unroll
          for (int kt = 0; kt < 8; ++kt) { Sb[kt][0] = cvtpk(Sacc[kt][0], Sacc[kt][1]); Sb[kt][1] = cvtpk(Sacc[kt][2], Sacc[kt][3]); }
#pragma unroll
          for (int ti = 0; ti < 4; ++ti) { O[ti] = (f32x4){0.f, 0.f, 0.f, 0.f};
#pragma unroll
              for (int ks = 0; ks < 4; ++ks) { const int rq = 16 * ti + l16;
                  const bf16x8_t Aq = *(const LAS bf16x8_t*)(L + QS + rq * 256 + (((4 * ks + quad) ^ (rq & 15)) * 16));
                  const v4u Bu = (v4u){Sb[2 * ks][0], Sb[2 * ks][1], Sb[2 * ks + 1][0], Sb[2 * ks + 1][1]};
                  O[ti] = __builtin_amdgcn_mfma_f32_16x16x32_bf16(Aq, __builtin_bit_cast(bf16x8_t, Bu), O[ti], 0, 0, 0); } } }
        const v4u g0 = *(const LAS v4u*)(L + GS + t_o * 256 + part * 32), g1 = *(const LAS v4u*)(L + GS + t_o * 256 + part * 32 + 16);
        LBAR();
        { bf16x8_t Bv[2];
#pragma unroll
          for (int p = 0; p < 2; ++p) Bv[p] = *(const LAS bf16x8_t*)(L + VT + vrow * TS + (32 * p + 8 * quad) * 2);
#pragma unroll
          for (int ti = 0; ti < 4; ++ti)
#pragma unroll
              for (int p = 0; p < 2; ++p) if (2 * p <= ti) { const bf16x8_t Ap = *(const LAS bf16x8_t*)(L + PS + (16 * ti + l16) * TS + (32 * p + 8 * quad) * 2);
                  O[ti] = __builtin_amdgcn_mfma_f32_16x16x32_bf16(Ap, Bv[p], O[ti], 0, 0, 0); }
#pragma unroll
          for (int kt = 0; kt < 8; ++kt) { const int kb = 32 * (kt >> 1) + 4 * (kt & 1);
              const f32x4 d4 = *(const LAS f32x4*)(L + DEC + (kb + 8 * quad) * 4); Sacc[kt] = Sacc[kt] * d4;
              const int kdr = kb + 8 * (l16 >> 2) + (l16 & 3);
#pragma unroll
              for (int ks = 0; ks < 2; ++ks) { const bf16x8_t Ak = *(const LAS bf16x8_t*)(L + KT + kdr * TS + (32 * ks + 8 * quad) * 2);
                  Sacc[kt] = __builtin_amdgcn_mfma_f32_16x16x32_bf16(Ak, Bv[ks], Sacc[kt], 0, 0, 0); } } }
#pragma unroll
        for (int ti = 0; ti < 4; ++ti)
#pragma unroll
            for (int j = 0; j < 4; ++j) *(LAS float*)(L + OS + (16 * ti + 4 * quad + j) * OSS + vrow * 4) = O[ti][j];
        LBAR();
        { const LAS f32x4* op = (const LAS f32x4*)(L + OS + t_o * OSS + part * 64);
          const f32x4 o0 = op[0], o1 = op[1], o2 = op[2], o3 = op[3];
          float ss = ((o0.x * o0.x + o0.y * o0.y) + (o0.z * o0.z + o0.w * o0.w)) + ((o1.x * o1.x + o1.y * o1.y) + (o1.z * o1.z + o1.w * o1.w))
                   + ((o2.x * o2.x + o2.y * o2.y) + (o2.z * o2.z + o2.w * o2.w)) + ((o3.x * o3.x + o3.y * o3.y) + (o3.z * o3.z + o3.w * o3.w));
          ss += __shfl_xor(ss, 1); ss += __shfl_xor(ss, 2); ss += __shfl_xor(ss, 4);
          const float rstd = __builtin_amdgcn_rsqf(ss * (1.0f / HD) + EPS);
          const f32x4 r0 = o0 * rstd * nw[0] * (f32x4){bf_lo(g0.x), bf_hi(g0.x), bf_lo(g0.y), bf_hi(g0.y)}, r1 = o1 * rstd * nw[1] * (f32x4){bf_lo(g0.z), bf_hi(g0.z), bf_lo(g0.w), bf_hi(g0.w)};
          const f32x4 r2 = o2 * rstd * nw[2] * (f32x4){bf_lo(g1.x), bf_hi(g1.x), bf_lo(g1.y), bf_hi(g1.y)}, r3 = o3 * rstd * nw[3] * (f32x4){bf_lo(g1.z), bf_hi(g1.z), bf_lo(g1.w), bf_hi(g1.w)};
          GAS v4u* dst = (GAS v4u*)(F.MIX + (size_t)(b * SEQ + t0 + t_o) * D + LRUW + h * HD + 16 * part);
          dst[0] = (v4u){cvtpk(r0.x, r0.y), cvtpk(r0.z, r0.w), cvtpk(r1.x, r1.y), cvtpk(r1.z, r1.w)}; dst[1] = (v4u){cvtpk(r2.x, r2.y), cvtpk(r2.z, r2.w), cvtpk(r3.x, r3.y), cvtpk(r3.z, r3.w)}; }
    }
    __syncthreads();
}

__device__ __forceinline__ void lru_unit(Frame& F, int b, int blk) {
    constexpr int XR = 0, XF = 17408, XH = 50176, XHS = 272, AS = 67584, US = 100352, SGA = 133120, SGU = SGA + 2048, HST = SGU + 2048;
    LAS unsigned char* L = F.lds;
    const int tid = F.tid, lane = F.lane, w = F.wave, quad = lane >> 4, l16 = lane & 15;
    const int e_own = tid & 127, seg = tid >> 7, chc = blk * LBD + e_own;
    const int em = 16 * w + l16, chm = blk * LBD + em;
    const float cw0 = F.lru_conv_w[chc], cw1 = F.lru_conv_w[LRUW + chc], cw2 = F.lru_conv_w[2 * LRUW + chc], cw3 = F.lru_conv_w[3 * LRUW + chc], cbv = F.lru_conv_b[chc];
    const float nba = -1.44269504089f * F.lru_ba[chm], nbx = -1.44269504089f * F.lru_bx[chm];
    const float lam = F.lru_lambda[chm];
    const float c2 = 16.0f * (fmaxf(-lam, 0.f) + log1pf(expf(-fabsf(lam))));
    bf16x8_t Bwa[4], Bwx[4];
#pragma unroll
    for (int ks = 0; ks < 4; ++ks)
#pragma unroll
        for (int i = 0; i < 8; ++i) { const int d = 32 * ks + 8 * quad + i;
            Bwa[ks][i] = (short)f2bf(F.lru_wa[((size_t)blk * LBD + d) * LBD + em]); Bwx[ks][i] = (short)f2bf(F.lru_wx[((size_t)blk * LBD + d) * LBD + em]); }
    if (tid < 256) ((LAS float*)(L + HST))[tid] = 0.f;
    const bf16* xsrc = F.PROJ + (size_t)(b * SEQ) * NIN + 4 * HGW + blk * LBD;
    const bf16* ysrc = xsrc + LRUW;
    v4u px[3]; unsigned short py[16];
#pragma unroll
    for (int it = 0; it < 3; ++it) { const int p = tid + 512 * it; px[it] = (v4u){0u, 0u, 0u, 0u}; if (p < 67 * 16) { const int row = p >> 4, s16 = p & 15, t = row - 3; if (t >= 0) px[it] = *(const GAS v4u*)(xsrc + (size_t)t * NIN + s16 * 8); } }
#pragma unroll
    for (int i = 0; i < 16; ++i) py[i] = *(const GAS unsigned short*)(ysrc + (size_t)(16 * seg + i) * NIN + e_own);
    for (int c = 0; c < SEQ / 64; ++c) {
        const int t0 = 64 * c;
#pragma unroll
        for (int it = 0; it < 3; ++it) { const int p = tid + 512 * it; if (p < 67 * 16) { const int row = p >> 4, s16 = p & 15; *(LAS v4u*)(L + XR + row * 256 + s16 * 16) = px[it]; } }
        LBAR();
        if (c + 1 < SEQ / 64) {
#pragma unroll
            for (int it = 0; it < 3; ++it) { const int p = tid + 512 * it; if (p < 67 * 16) { const int row = p >> 4, s16 = p & 15; px[it] = *(const GAS v4u*)(xsrc + (size_t)(t0 + 61 + row) * NIN + s16 * 8); } }
        }
        { const LAS unsigned short* xr = (const LAS unsigned short*)(L + XR) + e_own;
          float x0 = __builtin_bit_cast(float, (unsigned)xr[(16 * seg + 0) * 128] << 16), x1 = __builtin_bit_cast(float, (unsigned)xr[(16 * seg + 1) * 128] << 16), x2 = __builtin_bit_cast(float, (unsigned)xr[(16 * seg + 2) * 128] << 16);
#pragma unroll
          for (int i = 0; i < 16; ++i) { const int t = 16 * seg + i; const float x3 = __builtin_bit_cast(float, (unsigned)xr[(t + 3) * 128] << 16);
              const float xb = cbv + cw0 * x0 + cw1 * x1 + cw2 * x2 + cw3 * x3;
              ((LAS float*)(L + XF))[t * 128 + e_own] = xb; *(LAS unsigned short*)(L + XH + t * XHS + e_own * 2) = (unsigned short)cvtpk(xb, xb);
              x0 = x1; x1 = x2; x2 = x3; } }
        LBAR();
#pragma unroll 1
        for (int mt = 0; mt < 4; ++mt) {
            f32x4 R = (f32x4){0.f, 0.f, 0.f, 0.f}, I = R;
#pragma unroll
            for (int ks = 0; ks < 4; ++ks) { const bf16x8_t A = *(const LAS bf16x8_t*)(L + XH + (16 * mt + l16) * XHS + (32 * ks + 8 * quad) * 2);
                R = __builtin_amdgcn_mfma_f32_16x16x32_bf16(A, Bwa[ks], R, 0, 0, 0); I = __builtin_amdgcn_mfma_f32_16x16x32_bf16(A, Bwx[ks], I, 0, 0, 0); }
            f32x4 e1, e2;
#pragma unroll
            for (int j = 0; j < 4; ++j) { e1[j] = __builtin_amdgcn_exp2f(R[j] * -1.44269504089f + nba); e2[j] = __builtin_amdgcn_exp2f(I[j] * -1.44269504089f + nbx); }
            const f32x4 d1 = e1 + 1.0f, d2 = e2 + 1.0f, dd = d1 * d2;
            f32x4 inv;
#pragma unroll
            for (int j = 0; j < 4; ++j) inv[j] = __builtin_amdgcn_rcpf(dd[j]);
            const f32x4 r = inv * d2, ig = inv * d1, z = r * c2;
            f32x4 av = 1.0f + z * (-0.5f + z * (0.125f + z * ((-1.0f / 48.0f) + z * ((1.0f / 384.0f) + z * (-1.0f / 3840.0f)))));
            f32x4 om = z * (1.0f + z * (-0.5f + z * ((1.0f / 6.0f) + z * ((-1.0f / 24.0f) + z * ((1.0f / 120.0f) + z * (-1.0f / 720.0f))))));
            const bool big = (z[0] > 0.35f) | (z[1] > 0.35f) | (z[2] > 0.35f) | (z[3] > 0.35f);
            if (__builtin_amdgcn_ballot_w64(big) != 0ull) {
#pragma unroll
                for (int j = 0; j < 4; ++j) if (z[j] > 0.35f) { av[j] = fexp(-0.5f * z[j]); om[j] = 1.0f - av[j] * av[j]; } }
            f32x4 mult;
#pragma unroll
            for (int j = 0; j < 4; ++j) mult[j] = __builtin_amdgcn_sqrtf(om[j]);
            if (c == 0 && mt == 0 && quad == 0) mult[0] = 1.0f;
            const LAS float* xf = (const LAS float*)(L + XF) + (16 * mt + 4 * quad) * 128 + em;
            const f32x4 xbv = (f32x4){xf[0], xf[128], xf[256], xf[384]};
            const f32x4 uv = xbv * ig * mult;
            LAS float* ap = (LAS float*)(L + AS) + (16 * mt + 4 * quad) * 128 + em; LAS float* up = (LAS float*)(L + US) + (16 * mt + 4 * quad) * 128 + em;
#pragma unroll
            for (int j = 0; j < 4; ++j) { ap[j * 128] = av[j]; up[j * 128] = uv[j]; } }
        LBAR();
        { const LAS float* as = (const LAS float*)(L + AS) + e_own; const LAS float* us = (const LAS float*)(L + US) + e_own;
          float Aacc = 1.0f, Uacc = 0.0f;
#pragma unroll
          for (int i = 0; i < 16; ++i) { const int t = 16 * seg + i; const float a = as[t * 128], u = us[t * 128]; Uacc = a * Uacc + u; Aacc *= a; }
          ((LAS float*)(L + SGA))[seg * 128 + e_own] = Aacc; ((LAS float*)(L + SGU))[seg * 128 + e_own] = Uacc;
          LBAR();
          float h = ((LAS float*)(L + HST))[(c & 1) * 128 + e_own];
#pragma unroll
          for (int s2 = 0; s2 < 3; ++s2) if (s2 < seg) h = ((LAS float*)(L + SGA))[s2 * 128 + e_own] * h + ((LAS float*)(L + SGU))[s2 * 128 + e_own];
#pragma unroll
          for (int i = 0; i < 16; ++i) { const int t = 16 * seg + i; const float a = as[t * 128], u = us[t * 128]; h = a * h + u;
              ((LAS float*)(L + AS))[t * 128 + e_own] = h * __builtin_bit_cast(float, (unsigned)py[i] << 16); }
          if (seg == 3) ((LAS float*)(L + HST))[((c + 1) & 1) * 128 + e_own] = h;
          if (c + 1 < SEQ / 64) {
#pragma unroll
              for (int i = 0; i < 16; ++i) py[i] = *(const GAS unsigned short*)(ysrc + (size_t)(t0 + 64 + 16 * seg + i) * NIN + e_own); } }
        LBAR();
        { const int t = tid >> 3, part = tid & 7; const LAS f32x4* o4 = (const LAS f32x4*)(L + AS + (t * 128 + 16 * part) * 4);
          const f32x4 o0 = o4[0], o1 = o4[1], o2 = o4[2], o3 = o4[3];
          float ss = ((o0.x * o0.x + o0.y * o0.y) + (o0.z * o0.z + o0.w * o0.w)) + ((o1.x * o1.x + o1.y * o1.y) + (o1.z * o1.z + o1.w * o1.w))
                   + ((o2.x * o2.x + o2.y * o2.y) + (o2.z * o2.z + o2.w * o2.w)) + ((o3.x * o3.x + o3.y * o3.y) + (o3.z * o3.z + o3.w * o3.w));
          ss += __shfl_xor(ss, 1); ss += __shfl_xor(ss, 2); ss += __shfl_xor(ss, 4);
          const size_t row = (size_t)(b * SEQ + t0 + t);
          v4u p0, p1; p0.x = cvtpk(o0.x, o0.y); p0.y = cvtpk(o0.z, o0.w); p0.z = cvtpk(o1.x, o1.y); p0.w = cvtpk(o1.z, o1.w); p1.x = cvtpk(o2.x, o2.y); p1.y = cvtpk(o2.z, o2.w); p1.z = cvtpk(o3.x, o3.y); p1.w = cvtpk(o3.z, o3.w);
          GAS v4u* dst = (GAS v4u*)(F.MIX + row * D + blk * LBD + 16 * part); dst[0] = p0; dst[1] = p1;
          if (part == 0) F.SSQL[(size_t)blk * M + row] = ss; }
    }
    __syncthreads();
}

constexpr int N_PHASES = 10;
struct Args { const float* in[20]; float* out; unsigned char* ws; int ph_lo, ph_hi; };
__global__ void __launch_bounds__(NWAVES * 64, 2) fwd_kernel(Args args) {
    extern __shared__ __attribute__((aligned(16))) unsigned char lds[];
    Frame F;
    F.lds = (LAS unsigned char*)lds;
    F.MISC = (volatile LAS unsigned*)(F.lds + MISC_OFF);
    F.tid = threadIdx.x; F.lane = F.tid & 63; F.wave = __builtin_amdgcn_readfirstlane(F.tid >> 6);
    F.G = gridDim.x; { const int bx = blockIdx.x; F.vcu = (F.G % 8 == 0) ? (bx % 8) * (F.G / 8) + bx / 8 : bx; }
    unsigned char* ws = args.ws;
    F.ctl = (gu32*)(ws + WS_CTL);
    F.x = args.in[0]; F.ln1_w = args.in[1]; F.w_in = args.in[2]; F.lb_gamma = args.in[3]; F.hg_norm_w = args.in[4]; F.lru_conv_w = args.in[5]; F.lru_conv_b = args.in[6];
    F.lru_wa = args.in[7]; F.lru_ba = args.in[8]; F.lru_wx = args.in[9]; F.lru_bx = args.in[10]; F.lru_lambda = args.in[11]; F.lru_norm_w = args.in[12]; F.w_out = args.in[13];
    F.ln2_w = args.in[14]; F.w_up = args.in[15]; F.ffn_conv_w = args.in[16]; F.ffn_conv_b = args.in[17]; F.w_down = args.in[18]; F.final_norm_w = args.in[19]; F.out = args.out;
    F.Win_t = (bf16*)(ws + WS_WIN); F.Wout_t = (bf16*)(ws + WS_WOUT); F.Wup_t = (bf16*)(ws + WS_WUP); F.Wdn_t = (bf16*)(ws + WS_WDN);
    F.XN = (bf16*)(ws + WS_XN); F.PROJ = (bf16*)(ws + WS_PROJ); F.MIX = (bf16*)(ws + WS_MIX); F.ACT = (bf16*)(ws + WS_ACT);
    F.SIDE = (float*)(ws + WS_SIDE); F.SSQL = (float*)(ws + WS_SSQL); F.SSQ2 = (float*)(ws + WS_SSQ2); F.RSTG = (float*)(ws + WS_RSTG);
    for (int u = F.tid; u < (LDS_BYTES - LDSCTL_OFF) / 4; u += NWAVES * 64) ((LAS unsigned*)(F.lds + LDSCTL_OFF))[u] = 0u;
    __syncthreads();
    XcdBarrier bar; bar.bar = (unsigned*)(F.ctl + CW_BAR); bar.x = 0; bar.st = nullptr;
    if (MK_N_LAUNCHES == 1) bar = xcd_barrier_post((unsigned*)(F.ctl + CW_BAR), F.MISC + 8);
    const int lo = args.ph_lo, hi = args.ph_hi;
#define IN(k) (lo <= (k) && (k) < hi)
#define SEAM(k) do { if (IN(k) && IN((k) + 1)) xcd_barrier(bar); } while (0)
    const int gw = F.vcu * NWAVES + F.wave, NGW = F.G * NWAVES;

    if (IN(0)) { p0_prologue(F); } SEAM(0);
    if (IN(1)) { pg8::Gemm g{F.XN, F.Win_t, M, NIN, D}; pg8::StaticOrder S; S.init(M, NIN, F.G, (int)blockIdx.x);
        EpiProj E{F.PROJ, F.lb_gamma};
        pg8::gemm_phase<EpiProj, pg8::StaticOrder, PG8_ALIGN, PG8_SP2, false>(F.lds + RING_OFF, g, S, E); } SEAM(1);
    if (IN(2)) { const int half = F.G >> 1;
        if (F.vcu < half) { for (int u = F.vcu; u < 128; u += half) hgrn_unit(F, u >> 4, u & 15); }
        else { for (int u = F.vcu - half; u < 128; u += half) lru_unit(F, u >> 4, u & 15); }
        p_convert_w<1>(F); }
    if (IN(2) && IN(4)) xcd_barrier(bar);
    if (IN(4)) { LAS float* RSTL = (LAS float*)(F.lds + RING_BYTES); const int x8 = (int)(blockIdx.x & 7);
        for (int r = F.tid; r < 2048; r += NWAVES * 64) { const size_t row = (size_t)2048 * x8 + r; float sacc = 0.f;
#pragma unroll
            for (int q = 0; q < 16; ++q) sacc += F.SSQL[(size_t)q * M + row];
            RSTL[r] = __builtin_amdgcn_rsqf(sacc * (1.0f / LRUW) + EPS); }
        __syncthreads();
        pg8::Gemm g{F.MIX, F.Wout_t, M, D, D}; pg8::StaticOrder S; S.init(M, D, F.G, (int)blockIdx.x);
        EpiRes2 E{F.x, F.XN, F.SSQ2};
        pg8::gemm_phase<EpiRes2, pg8::StaticOrder, PG8_ALIGN, PG8_SP2, false, true>(F.lds + RING_OFF, g, S, E, RSTL, 8 * x8);
        p_convert_w<2>(F); }
    if (IN(4) && IN(6)) xcd_barrier(bar);
    if (IN(6)) { LAS float* RST = (LAS float*)(F.lds + RING_BYTES); const int x8 = (int)(blockIdx.x & 7);
        for (int r = F.tid; r < 2048; r += NWAVES * 64) { const GAS f32x4* p = (const GAS f32x4*)(F.SSQ2 + (size_t)(2048 * x8 + r) * 64); float sacc = 0.f;
#pragma unroll
            for (int q = 0; q < 16; ++q) { const f32x4 v = p[q]; sacc += (v.x + v.y) + (v.z + v.w); }
            const float rv = __builtin_amdgcn_rsqf(sacc * (1.0f / D) + EPS); RST[r] = rv;
            if (F.G != 256 || (r >> 6) == (int)(blockIdx.x >> 3)) __hip_atomic_store(F.RSTG + (size_t)2048 * x8 + r, rv, RLX_AGENT); }
        __syncthreads();
        pg8::Gemm g{F.XN, F.Wup_t, M, NUP, D}; pg8::DynTailOrder S; S.init2(M, NUP, F.G, (int)blockIdx.x, (unsigned*)(F.ctl + 32), (volatile LAS unsigned*)(F.MISC + 24));
        EpiUp E{F.ACT, F.SIDE, F.ffn_conv_w, F.ffn_conv_b, RST, 8 * x8, F.RSTG};
        pg8::gemm_phase<EpiUp, pg8::DynTailOrder, PG8_ALIGN, PG8_SP2, true>(F.lds + RING_OFF, g, S, E);
        p_convert_wdown(F, F.vcu, F.G); }
    SEAM(6);
    if (IN(7)) { const size_t total = (size_t)NSTRIP * DFF;
        for (size_t i = (size_t)F.vcu * 512 + F.tid; i < total; i += (size_t)F.G * 512) { const int s = (int)(i / DFF), c = (int)(i % DFF);
            if ((s & 15) == 0) continue;
            const float* sp = F.SIDE + (size_t)(s - 1) * 4 * NUP; const float* sc = F.SIDE + (size_t)s * 4 * NUP;
            const float gm2 = sp[2 * (size_t)NUP + c], gm1 = sp[3 * (size_t)NUP + c], g0 = sc[c], g1 = sc[(size_t)NUP + c];
            const float vm2 = sp[2 * (size_t)NUP + DFF + c], vm1 = sp[3 * (size_t)NUP + DFF + c], v0 = sc[DFF + c], v1 = sc[(size_t)NUP + DFF + c];
            const float wg0 = F.ffn_conv_w[c], wg1 = F.ffn_conv_w[NUP + c], wg2 = F.ffn_conv_w[2 * NUP + c], bg = F.ffn_conv_b[c];
            const float wv0 = F.ffn_conv_w[DFF + c], wv1 = F.ffn_conv_w[NUP + DFF + c], wv2 = F.ffn_conv_w[2 * NUP + DFF + c], bv = F.ffn_conv_b[DFF + c];
            const float cg0 = bg + wg2 * g0 + wg1 * gm1 + wg0 * gm2, cv0 = bv + wv2 * v0 + wv1 * vm1 + wv0 * vm2;
            const float cg1 = bg + wg2 * g1 + wg1 * g0 + wg0 * gm1, cv1 = bv + wv2 * v1 + wv1 * v0 + wv0 * vm1;
            F.ACT[(size_t)(s * 128) * DFF + c] = (bf16)f2bf(siluf_(cg0) * cv0); F.ACT[(size_t)(s * 128 + 1) * DFF + c] = (bf16)f2bf(siluf_(cg1) * cv1); } } SEAM(7);
    if (IN(8)) { pg8::Gemm g{F.ACT, F.Wdn_t, M, D, DFF}; pg8::StaticOrder S; S.init(M, D, F.G, (int)blockIdx.x);
        EpiRes4 E{F.XN};
        pg8::gemm_phase<EpiRes4, pg8::StaticOrder, PG8_ALIGN, PG8_SP2, false>(F.lds + RING_OFF, g, S, E); } SEAM(8);
    if (IN(9)) { for (int m = gw; m < M; m += NGW) rms_row_bf16_to_f32(F.lane, F.XN + (size_t)m * D, F.final_norm_w, F.out + (size_t)m * D); }
#undef IN
#undef SEAM
}

extern "C" void kernel_launch(void* const* d_in, const int* in_sizes, int n_in, void* d_out, int out_size, void* d_ws, size_t ws_size, hipStream_t stream) {
    static int grid = 0;
    if (grid == 0) {
        if (n_in != 20 || in_sizes[0] != M * D || out_size != M * D || ws_size < WS_END) { fprintf(stderr, "kernel_launch: unexpected shapes (n_in %d, in0 %d, out %d, ws %zu < %zu); nothing launched\n", n_in, n_in > 0 ? in_sizes[0] : -1, out_size, ws_size, (size_t)WS_END); grid = -1; return; }
        int dev = 0, cus = 0, per_cu = 0;
        if (hipGetDevice(&dev) != hipSuccess || hipDeviceGetAttribute(&cus, hipDeviceAttributeMultiprocessorCount, dev) != hipSuccess) { grid = -1; return; }
        if (hipFuncSetAttribute((const void*)fwd_kernel, hipFuncAttributeMaxDynamicSharedMemorySize, LDS_BYTES) != hipSuccess) { fprintf(stderr, "kernel_launch: hipFuncSetAttribute failed\n"); grid = -1; return; }
        if (hipOccupancyMaxActiveBlocksPerMultiprocessor(&per_cu, (const void*)fwd_kernel, NWAVES * 64, LDS_BYTES) != hipSuccess || per_cu < 1)
            fprintf(stderr, "kernel_launch: note: occupancy query reports %d workgroups per CU\n", per_cu);
        (void)hipGetLastError();
        grid = cus;
    }
    if (grid < 0) return;
    if (hipMemsetAsync((char*)d_ws + WS_CTL, 0, CTL_ZERO_BYTES, stream) != hipSuccess) return;
    Args a{};
    for (int i = 0; i < 20; ++i) a.in[i] = (const float*)d_in[i];
    a.out = (float*)d_out; a.ws = (unsigned char*)d_ws;
    if (MK_N_LAUNCHES == 1) { a.ph_lo = 0; a.ph_hi = N_PHASES; hipLaunchKernelGGL(fwd_kernel, dim3(grid), dim3(NWAVES * 64), LDS_BYTES, stream, a); }
    else for (int p = 0; p < N_PHASES; ++p) { a.ph_lo = p; a.ph_hi = p + 1; hipLaunchKernelGGL(fwd_kernel, dim3(grid), dim3(NWAVES * 64), LDS_BYTES, stream, a); }
}
```

```cpp
#include <hip/hip_runtime.h>
#include <cstdio>
#include <cstdint>

#ifndef MK_N_LAUNCHES
#define MK_N_LAUNCHES 1
#endif

namespace pg8 {
#define PG8_LAS __attribute__((address_space(3)))
typedef unsigned short bf16_t;
typedef short bf16x8 __attribute__((ext_vector_type(8)));
typedef float f32x4 __attribute__((ext_vector_type(4)));
typedef unsigned u32x4 __attribute__((ext_vector_type(4)));
typedef unsigned u32x2 __attribute__((ext_vector_type(2)));
constexpr int BM = 256, BK = 64, HALF = 128, HTB = HALF * BK * 2, STAGE_BYTES = 8 * HTB, NXCD = 8, WGM = 8;

__host__ __device__ __forceinline__ int lds_byte(int r, int c) { const int st = (r >> 4) * 2 + (c >> 5), rr = r & 15, cc = c & 31, ob = rr * 64 + cc * 2; return st * 1024 + (ob ^ (((ob >> 9) & 1) << 5)); }
__host__ __device__ __forceinline__ void stage_rc(int b, int& R, int& C) { const int st = b / 1024, sb = b % 1024, swz = sb ^ (((sb >> 9) & 1) << 5); R = (st >> 1) * 16 + swz / 64; C = (st & 1) * 32 + (swz % 64) / 2; }
__host__ __device__ __forceinline__ int perm32(int rho) { const int n = rho >> 4, i = rho & 15; return 8 * (i >> 2) + 4 * n + (i & 3); }

struct Unit { int pm, pn, par; };
struct Gemm { const bf16_t* A; const bf16_t* Bt; int M, N, K; };

struct StaticOrder {
    int nM, nN, nwg, G, c;
    __host__ __device__ void init(int M, int N, int G_, int c_) { nM = M / BM; nN = N / BM; nwg = nM * nN; G = G_; c = c_; }
    __host__ __device__ bool next(int i, Unit& u) const {
        const long L = (long)i * G + c; if (L >= nwg) return false;
        int wgid = (int)L; { const int q = nwg / NXCD, r = nwg % NXCD, xcd = wgid % NXCD, off = wgid / NXCD; wgid = (xcd < r ? xcd * (q + 1) : r * (q + 1) + (xcd - r) * q) + off; }
        const int nig = WGM * nN, gid = wgid / nig, fm = gid * WGM, gsz = (nM - fm) < WGM ? (nM - fm) : WGM;
        u.pm = fm + ((wgid % nig) % gsz); u.pn = (wgid % nig) / gsz; return true;
    }
    __device__ __forceinline__ void a_ready(const Unit&) const {}
    __device__ __forceinline__ void done(const Unit&) const {}
};

__device__ __forceinline__ unsigned cvt_pk_bf16(float lo, float hi) { unsigned r; asm volatile("v_cvt_pk_bf16_f32 %0, %1, %2" : "=v"(r) : "v"(lo), "v"(hi)); return r; }

struct DynTailOrder : StaticOrder {
    unsigned* counter; volatile PG8_LAS unsigned* slot; int nstatic, ntail;
    __device__ __forceinline__ void init2(int M, int N, int G_, int c_, unsigned* counter_, volatile PG8_LAS unsigned* slot_) { init(M, N, G_, c_); counter = counter_; slot = slot_; nstatic = nwg / G; ntail = nwg % G; }
    __device__ __forceinline__ bool next(int i, Unit& u) const {
        if (i < nstatic) return StaticOrder::next(i, u);
        if (i > nstatic || ntail == 0) return false;
        if (threadIdx.x == 0) { const unsigned t = __hip_atomic_fetch_add(counter, 1u, __ATOMIC_RELAXED, __HIP_MEMORY_SCOPE_AGENT); *slot = t; }
        asm volatile("s_waitcnt lgkmcnt(0)" ::: "memory"); __builtin_amdgcn_s_barrier(); asm volatile("" ::: "memory");
        const unsigned t = *slot;
        if (t >= (unsigned)ntail) return false;
        StaticOrder T = *this; T.c = (int)t;
        return T.StaticOrder::next(nstatic, u);
    }
};

template <class Epi, class Sched, bool ALIGN_EPI = false, bool SP2 = false, int AROWPERM = 0, bool MIDSCALE = false>
__device__ __forceinline__ void gemm_phase(PG8_LAS unsigned char* lds, const Gemm g, const Sched& S, const Epi& E, const PG8_LAS float* midtab = nullptr, int midpm0 = 0) {
    const int tid = threadIdx.x, wid = __builtin_amdgcn_readfirstlane(tid >> 6), lane = tid & 63, wr = wid >> 2, wc = wid & 3, fr = lane & 15, fq = lane >> 4;
    const int K = g.K, nt = K / BK;
    unsigned voffA[2], voffB[2];
#pragma unroll
    for (int i = 0; i < 2; ++i) { int R, C; stage_rc(tid * 16 + i * 8192, R, C); const int Rb = Epi::PERM ? ((R & ~31) + perm32(R & 31)) : R;
        const int Ra = AROWPERM == 2 ? (128 * (R >> 6) + 8 * (R & 15) + ((R >> 4) & 3)) : AROWPERM == 1 ? (128 * (R >> 6) + (R & 63)) : R;
        voffA[i] = (unsigned)(Ra * K + C) * 2u; voffB[i] = (unsigned)(Rb * K + C) * 2u; }
    const size_t kstep = (size_t)(BK * 2);
    const size_t hstepB = (size_t)HALF * K * 2;
    const size_t hstepA = AROWPERM == 2 ? (size_t)4 * K * 2 : AROWPERM == 1 ? (size_t)64 * K * 2 : (size_t)HALF * K * 2;
    const size_t tstep = (size_t)BM * K * 2;
    const unsigned ldsw = (unsigned)wid * 1024u;
    const int aoff = lds_byte(wr * 64 + fr, fq * 8), boff = lds_byte(wc * 32 + fr, fq * 8);
#define PG8_SA(b, h) (((b) * 2 + (h)) * HTB)
#define PG8_SB(b, h) ((4 + (b) * 2 + (h)) * HTB)
#define PG8_STAGE(bufoff, gbase, voff) do { _Pragma("unroll") for (int _i = 0; _i < 2; ++_i) \
        __builtin_amdgcn_global_load_lds((const unsigned*)((const char*)(gbase) + (voff)[_i]), (PG8_LAS unsigned*)(lds + (bufoff) + ldsw + _i * 8192), 16, 0, 0); } while (0)
#define PG8_LDA(dst, b, h) do { _Pragma("unroll") for (int m = 0; m < 4; ++m) _Pragma("unroll") for (int k = 0; k < 2; ++k) dst[m][k] = *(const PG8_LAS bf16x8*)(lds + PG8_SA(b, h) + aoff + m * 2048 + k * 1024); } while (0)
#define PG8_LDB(dst, b, h) do { _Pragma("unroll") for (int n = 0; n < 2; ++n) _Pragma("unroll") for (int k = 0; k < 2; ++k) dst[n][k] = *(const PG8_LAS bf16x8*)(lds + PG8_SB(b, h) + boff + n * 2048 + k * 1024); } while (0)
#define PG8_MMA(ai, bj, At, Bt) do { __builtin_amdgcn_s_setprio(1); _Pragma("unroll") for (int m = 0; m < 4; ++m) _Pragma("unroll") for (int n = 0; n < 2; ++n) _Pragma("unroll") for (int k = 0; k < 2; ++k) \
        acc[ai][bj][m][n] = __builtin_amdgcn_mfma_f32_16x16x32_bf16(Bt[n][k], At[m][k], acc[ai][bj][m][n], 0, 0, 0); __builtin_amdgcn_s_setprio(0); } while (0)
#define PG8_WAIT_V(n) asm volatile("s_waitcnt vmcnt(" #n ")" ::: "memory")
#define PG8_WAIT_L(n) asm volatile("s_waitcnt lgkmcnt(" #n ")" ::: "memory")
#define PG8_BAR __builtin_amdgcn_s_barrier()
#define PG8_SCHED __builtin_amdgcn_sched_barrier(0)
    Unit cur, nxt; int ui = 0;
    if (!S.next(0, cur)) return;
    f32x4 acc[2][2][4][2];
#pragma unroll
    for (int a = 0; a < 2; ++a)
#pragma unroll
        for (int b = 0; b < 2; ++b)
#pragma unroll
            for (int m = 0; m < 4; ++m)
#pragma unroll
                for (int n = 0; n < 2; ++n) acc[a][b][m][n] = (f32x4){0.f, 0.f, 0.f, 0.f};
    bf16x8 At[4][2], B0[2][2], B1[2][2];
    const char* cA = (const char*)g.A + (size_t)cur.pm * tstep; const char* cB = (const char*)g.Bt + (size_t)cur.pn * tstep;
    S.a_ready(cur);
    cur.par = 0;
    if constexpr (Epi::HAS_PRE) E.pre(cur, wid, lane);
    if constexpr (SP2) {
        PG8_STAGE(PG8_SB(0, 0), cB, voffB); PG8_STAGE(PG8_SB(0, 1), cB + hstepB, voffB); PG8_STAGE(PG8_SA(0, 0), cA, voffA); PG8_STAGE(PG8_SA(0, 1), cA + hstepA, voffA);
        if (wr == 1) PG8_BAR;
        PG8_WAIT_V(2); PG8_BAR;
        PG8_STAGE(PG8_SB(1, 0), cB + kstep, voffB); PG8_STAGE(PG8_SA(1, 0), cA + kstep, voffA); PG8_STAGE(PG8_SB(1, 1), cB + hstepB + kstep, voffB);
        PG8_WAIT_V(6); PG8_BAR;
    } else {
        PG8_STAGE(PG8_SB(0, 0), cB, voffB); PG8_STAGE(PG8_SA(0, 0), cA, voffA); PG8_STAGE(PG8_SB(0, 1), cB + hstepB, voffB); PG8_STAGE(PG8_SA(0, 1), cA + hstepA, voffA);
        if (wr == 1) PG8_BAR;
        PG8_WAIT_V(4); PG8_BAR;
        PG8_STAGE(PG8_SB(1, 0), cB + kstep, voffB); PG8_STAGE(PG8_SA(1, 0), cA + kstep, voffA); PG8_STAGE(PG8_SB(1, 1), cB + hstepB + kstep, voffB);
        PG8_WAIT_V(6); PG8_BAR;
    }
    for (;;) {
        const bool has_next = S.next(ui + 1, nxt);
        const char* nA = has_next ? (const char*)g.A + (size_t)nxt.pm * tstep : cA; const char* nB = has_next ? (const char*)g.Bt + (size_t)nxt.pn * tstep : cB;
        for (int t = 0; t < nt; t += 2) {
            const bool last = (t == nt - 2);
            const char* a1 = cA + (size_t)(t + 1) * kstep;
            const char* a2 = last ? nA : cA + (size_t)(t + 2) * kstep; const char* b2 = last ? nB : cB + (size_t)(t + 2) * kstep;
            const char* a3 = a2 + kstep; const char* b3 = b2 + kstep;
            if (last && has_next) S.a_ready(nxt);
            if constexpr (MIDSCALE) { if (t == nt / 2) {
#pragma unroll
                for (int a = 0; a < 2; ++a)
#pragma unroll
                    for (int m = 0; m < 4; ++m) { const float sc = midtab[(cur.pm - midpm0) * 256 + a * 128 + wr * 64 + m * 16 + fr];
#pragma unroll
                        for (int b = 0; b < 2; ++b)
#pragma unroll
                            for (int n = 0; n < 2; ++n) acc[a][b][m][n] = acc[a][b][m][n] * sc; } } }
            if constexpr (SP2) {
            PG8_LDB(B0, 0, 0); PG8_LDB(B1, 0, 1); PG8_SCHED; PG8_LDA(At, 0, 0); PG8_STAGE(PG8_SA(1, 1), a1 + hstepA, voffA);
            PG8_WAIT_V(8); PG8_WAIT_L(0); PG8_BAR; PG8_MMA(0, 0, At, B0); PG8_MMA(0, 1, At, B1); PG8_BAR; PG8_SCHED;
            PG8_LDA(At, 0, 1); PG8_STAGE(PG8_SB(0, 0), b2, voffB); PG8_STAGE(PG8_SB(0, 1), b2 + hstepB, voffB); PG8_STAGE(PG8_SA(0, 0), a2, voffA);
            PG8_WAIT_V(8); PG8_WAIT_L(0); PG8_BAR; PG8_MMA(1, 0, At, B0); PG8_MMA(1, 1, At, B1); PG8_BAR; PG8_SCHED;
            PG8_LDB(B0, 1, 0); PG8_LDB(B1, 1, 1); PG8_SCHED; PG8_LDA(At, 1, 0); PG8_STAGE(PG8_SA(0, 1), a2 + hstepA, voffA);
            PG8_WAIT_V(8); PG8_WAIT_L(0); PG8_BAR; PG8_MMA(0, 0, At, B0); PG8_MMA(0, 1, At, B1); PG8_BAR; PG8_SCHED;
            PG8_LDA(At, 1, 1); PG8_STAGE(PG8_SB(1, 0), b3, voffB); PG8_STAGE(PG8_SB(1, 1), b3 + hstepB, voffB); PG8_STAGE(PG8_SA(1, 0), a3, voffA);
            PG8_WAIT_V(8); PG8_WAIT_L(0); PG8_BAR; PG8_MMA(1, 0, At, B0); PG8_MMA(1, 1, At, B1); PG8_BAR; PG8_SCHED;
            } else {
            PG8_LDB(B0, 0, 0); PG8_SCHED; PG8_LDA(At, 0, 0); PG8_STAGE(PG8_SA(1, 1), a1 + hstepA, voffA);
            PG8_WAIT_L(8); PG8_BAR; PG8_WAIT_L(0); PG8_MMA(0, 0, At, B0); PG8_BAR; PG8_SCHED;
            PG8_LDB(B1, 0, 1); PG8_STAGE(PG8_SB(0, 0), b2, voffB);
            PG8_BAR; PG8_WAIT_L(0); PG8_MMA(0, 1, At, B1); PG8_BAR;
            PG8_LDA(At, 0, 1); PG8_STAGE(PG8_SA(0, 0), a2, voffA);
            PG8_BAR; PG8_WAIT_L(0); PG8_MMA(1, 0, At, B0); PG8_BAR; PG8_SCHED;
            PG8_STAGE(PG8_SB(0, 1), b2 + hstepB, voffB);
            PG8_WAIT_V(6); PG8_BAR; PG8_MMA(1, 1, At, B1); PG8_BAR;
            PG8_LDB(B0, 1, 0); PG8_SCHED; PG8_LDA(At, 1, 0); PG8_STAGE(PG8_SA(0, 1), a2 + hstepA, voffA);
            PG8_WAIT_L(8); PG8_BAR; PG8_WAIT_L(0); PG8_MMA(0, 0, At, B0); PG8_BAR; PG8_SCHED;
            PG8_LDB(B1, 1, 1); PG8_STAGE(PG8_SB(1, 0), b3, voffB);
            PG8_BAR; PG8_WAIT_L(0); PG8_MMA(0, 1, At, B1); PG8_BAR;
            PG8_LDA(At, 1, 1); PG8_STAGE(PG8_SA(1, 0), a3, voffA);
            PG8_BAR; PG8_WAIT_L(0); PG8_MMA(1, 0, At, B0); PG8_BAR; PG8_SCHED;
            PG8_STAGE(PG8_SB(1, 1), b3 + hstepB, voffB);
            PG8_WAIT_V(6); PG8_BAR; PG8_MMA(1, 1, At, B1); PG8_BAR;
            }
        }
        if constexpr (ALIGN_EPI) { if (wr == 0) PG8_BAR; }
        E(acc, cur, wr, wc, fr, fq); S.done(cur);
        if (!has_next) break;
#pragma unroll
        for (int a = 0; a < 2; ++a)
#pragma unroll
            for (int b = 0; b < 2; ++b)
#pragma unroll
                for (int m = 0; m < 4; ++m)
#pragma unroll
                    for (int n = 0; n < 2; ++n) acc[a][b][m][n] = (f32x4){0.f, 0.f, 0.f, 0.f};
        cur = nxt; cA = nA; cB = nB; ++ui; cur.par = ui & 1;
        if constexpr (Epi::HAS_PRE) E.pre(cur, wid, lane);
        if constexpr (ALIGN_EPI) { if (wr == 1) PG8_BAR; }
    }
    PG8_WAIT_V(0);
    if constexpr (!ALIGN_EPI) { if (wr == 0) PG8_BAR; }
    PG8_BAR;
#undef PG8_SA
#undef PG8_SB
#undef PG8_STAGE
#undef PG8_LDA
#undef PG8_LDB
#undef PG8_MMA
#undef PG8_WAIT_V
#undef PG8_WAIT_L
#undef PG8_BAR
#undef PG8_SCHED
}
}

#ifndef PG8_SP2
#define PG8_SP2 true
#endif
#ifndef PG8_ALIGN
#define PG8_ALIGN true
#endif

constexpr int NWAVES = 8;
constexpr int BATCH = 8, SEQ = 2048, D = 4096, M = BATCH * SEQ;
constexpr int HGW = 2048, HD = 128, NH = 16, LRUW = 2048, NLB = 16, LBD = 128;
constexpr int NIN = 12288, DFF = 11008, NUP = 2 * DFF;
constexpr float EPS = 1e-6f;
constexpr int NSTRIP = M / 128;

constexpr size_t MiB = 1u << 20;
constexpr size_t WS_CTL = 0, CTL_ZERO_BYTES = 1 * MiB;
constexpr size_t WS_WIN = 1 * MiB;
constexpr size_t WS_WOUT = WS_WIN + (size_t)NIN * D * 2;
constexpr size_t WS_WUP = WS_WOUT + (size_t)D * D * 2;
constexpr size_t WS_WDN = WS_WUP + (size_t)NUP * D * 2;
constexpr size_t WS_XN = WS_WDN + (size_t)D * DFF * 2;
constexpr size_t WS_PROJ = WS_XN + (size_t)M * D * 2;
constexpr size_t WS_ACT = WS_PROJ;
constexpr size_t WS_MIX = WS_PROJ + (size_t)M * NIN * 2;
constexpr size_t WS_SIDE = WS_MIX + (size_t)M * D * 2;
constexpr size_t WS_SSQL = WS_SIDE + (size_t)NSTRIP * 4 * NUP * 4;
constexpr size_t WS_SSQ2 = WS_SSQL + (size_t)16 * M * 4;
constexpr size_t WS_RSTG = WS_SSQ2 + (size_t)M * 64 * 4;
constexpr size_t WS_CT = WS_RSTG + (size_t)M * 4;
constexpr size_t WS_END = WS_CT + (size_t)(NUP / 256) * 1024 * 4;
constexpr int CW_TMO = 0, CW_CODE = 1, CW_BAR = 4096;

constexpr int RING_OFF = 0, RING_BYTES = 131072;
constexpr int LDSCTL_OFF = 143360, MISC_OFF = LDSCTL_OFF + 320;
constexpr int LDS_BYTES = 163840, WL_OFF = 147456;

#define GAS __attribute__((address_space(1)))
#define LAS __attribute__((address_space(3)))
typedef unsigned short bf16;
typedef unsigned v4u __attribute__((ext_vector_type(4)));
typedef unsigned v2u __attribute__((ext_vector_type(2)));
typedef float f32x4 __attribute__((ext_vector_type(4)));
typedef float f32x2 __attribute__((ext_vector_type(2)));
typedef GAS unsigned gu32;
#define RLX_AGENT __ATOMIC_RELAXED, __HIP_MEMORY_SCOPE_AGENT
#define LDS_WAIT() asm volatile("s_waitcnt lgkmcnt(0)" ::: "memory")
#define VM_WAIT() asm volatile("s_waitcnt vmcnt(0)" ::: "memory")
__device__ __forceinline__ unsigned f2bf(float f) { unsigned u = __builtin_bit_cast(unsigned, f); return (u + 0x7fffu + ((u >> 16) & 1u)) >> 16; }
__device__ __forceinline__ unsigned pk2(float lo, float hi) { return f2bf(lo) | (f2bf(hi) << 16); }
typedef __bf16 bf16x2_t __attribute__((ext_vector_type(2)));
__device__ __forceinline__ unsigned cvtpk(float lo, float hi) { const f32x2 v = {lo, hi}; const bf16x2_t b = __builtin_convertvector(v, bf16x2_t); return __builtin_bit_cast(unsigned, b); }
__device__ __forceinline__ float bf_lo(unsigned u) { return __builtin_bit_cast(float, u << 16); }
__device__ __forceinline__ float bf_hi(unsigned u) { return __builtin_bit_cast(float, u & 0xffff0000u); }
__device__ __forceinline__ float fexp(float x) { return __builtin_amdgcn_exp2f(x * 1.44269504089f); }
__device__ __forceinline__ float sigmoidf_(float x) { return __builtin_amdgcn_rcpf(1.0f + fexp(-x)); }
__device__ __forceinline__ float siluf_(float x) { return x * sigmoidf_(x); }
__device__ __forceinline__ float gelu_tanh_(float y) { const float z = 0.7978845608028654f * (y + 0.044715f * y * y * y); return y * sigmoidf_(2.0f * z); }

#define XB_TMO      128
#define XB_XCNT(j)  (256  + 64 * (j))
#define XB_XSUB(j)  (1280 + 64 * (j))
#define XB_XGEN(j)  (2304 + 64 * (j))
#define XB_TOP      3328
#define XB_TOPGEN   3392
#define XCD_BAR_WORDS 3456
#define XB_SPIN_CAP (1u << 18)
__device__ __forceinline__ unsigned xb_ld(unsigned* p)              { return __hip_atomic_load(p, __ATOMIC_RELAXED, __HIP_MEMORY_SCOPE_AGENT); }
__device__ __forceinline__ unsigned xb_add(unsigned* p, unsigned v) { return __hip_atomic_fetch_add(p, v, __ATOMIC_RELAXED, __HIP_MEMORY_SCOPE_AGENT); }
__device__ __forceinline__ unsigned xb_xcc_id() { return (unsigned)__builtin_amdgcn_s_getreg((3 << 11) | 20) & 0xFu; }
#define XB_SPIN(cond, bar) do { unsigned _sp = 0; while (cond) { __builtin_amdgcn_s_sleep(1); \
    if ((++_sp & 255u) == 0u) { if (xb_ld(&(bar)[XB_TMO])) break; if (_sp > XB_SPIN_CAP) { atomicAdd(&(bar)[XB_TMO], 1u); break; } } } } while (0)
struct XcdBarrier { unsigned* bar; unsigned x; volatile LAS unsigned* st; };
__device__ __forceinline__ XcdBarrier xcd_barrier_post(unsigned* bar, volatile LAS unsigned* st) {
    XcdBarrier b; b.bar = bar; b.x = xb_xcc_id(); b.st = st;
    if (threadIdx.x == 0) (void)xb_add(&bar[XB_XCNT(b.x)], 1u);
    return b;
}
__device__ __forceinline__ void xcd_barrier_complete(unsigned* bar, unsigned x, unsigned& nloc, unsigned& nx) {
    const unsigned G = gridDim.x * gridDim.y * gridDim.z;
    unsigned sum, cnt, mine, sp = 0u;
    for (;;) {
        sum = 0u; cnt = 0u; mine = 0u;
#pragma unroll
        for (unsigned j = 0; j < 16; ++j) { const unsigned c = xb_ld(&bar[XB_XCNT(j)]); sum += c; cnt += (c > 0u) ? 1u : 0u; mine = (j == x) ? c : mine; }
        if (sum == G) break;
        __builtin_amdgcn_s_sleep(1);
        if ((++sp & 255u) == 0u) { if (xb_ld(&bar[XB_TMO])) break; if (sp > XB_SPIN_CAP) { atomicAdd(&bar[XB_TMO], 1u); break; } }
    }
    nloc = mine > 0u ? mine : 1u; nx = cnt > 0u ? cnt : 1u;
}
__device__ __forceinline__ void xcd_barrier(const XcdBarrier& b) {
    asm volatile("s_waitcnt vmcnt(0)" ::: "memory");
    __syncthreads();
    if (threadIdx.x == 0) {
        unsigned* bar = b.bar;
        __builtin_amdgcn_s_waitcnt(0);
        unsigned nloc = b.st[0], nx = b.st[1];
        if (nloc == 0u) { xcd_barrier_complete(bar, b.x, nloc, nx); b.st[0] = nloc; b.st[1] = nx; }
        const unsigned old = xb_add(&bar[XB_XSUB(b.x)], 1u);
        const unsigned gen = old / nloc;
        if (old + 1u == (gen + 1u) * nloc) {
            __builtin_amdgcn_fence(__ATOMIC_RELEASE, "agent");
            asm volatile("s_waitcnt vmcnt(0)" ::: "memory");
            const unsigned og = xb_add(&bar[XB_TOP], 1u);
            const unsigned tg = og / nx;
            if (og + 1u == (tg + 1u) * nx) xb_add(&bar[XB_TOPGEN], 1u);
            else XB_SPIN(xb_ld(&bar[XB_TOPGEN]) == tg, bar);
            __builtin_amdgcn_fence(__ATOMIC_ACQUIRE, "agent");
            xb_add(&bar[XB_XGEN(b.x)], 1u);
            asm volatile("s_waitcnt vmcnt(0)" ::: "memory");
        } else {
            XB_SPIN(xb_ld(&bar[XB_XGEN(b.x)]) == gen, bar);
            __builtin_amdgcn_fence(__ATOMIC_ACQUIRE, "agent");
            asm volatile("s_waitcnt vmcnt(0)" ::: "memory");
        }
    }
    __syncthreads();
}

struct Frame {
    LAS unsigned char* lds;
    volatile LAS unsigned* MISC;
    gu32* ctl;
    int tid, lane, wave;
    int vcu, G;
    const float* x; float* out;
    const float *ln1_w, *w_in, *lb_gamma, *hg_norm_w, *lru_conv_w, *lru_conv_b, *lru_wa, *lru_ba, *lru_wx, *lru_bx, *lru_lambda, *lru_norm_w, *w_out, *ln2_w, *w_up, *ffn_conv_w, *ffn_conv_b, *w_down, *final_norm_w;
    bf16 *Win_t, *Wout_t, *Wup_t, *Wdn_t;
    bf16 *XN, *PROJ, *MIX, *ACT;
    float *SIDE, *SSQL, *SSQ2, *RSTG, *CT;
};

__device__ __forceinline__ float wave_sum(float v) {
#pragma unroll
    for (int o = 1; o < 64; o <<= 1) v += __shfl_xor(v, o);
    return v;
}

__device__ __forceinline__ void p0_transpose_item(const float* W, int N, bf16* WT, int ldt, int dst_row, int k0, int n0, LAS float* scr, int lane, const float* kscale = nullptr, int kdst = -1) {
    if (kdst < 0) kdst = k0;
#pragma unroll 8
    for (int i = 0; i < 32; ++i) { const int kk = 2 * i + (lane >> 5); scr[kk * 33 + (lane & 31)] = __builtin_nontemporal_load(&W[(size_t)(k0 + kk) * N + n0 + (lane & 31)]); }
    LDS_WAIT(); asm volatile("" ::: "memory");
    const int c = lane & 7;
    f32x4 sc0 = (f32x4){1.f, 1.f, 1.f, 1.f}, sc1 = sc0;
    if (kscale) { sc0 = *(const GAS f32x4*)(kscale + k0 + 8 * c); sc1 = *(const GAS f32x4*)(kscale + k0 + 8 * c + 4); }
#pragma unroll
    for (int j = 0; j < 4; ++j) { const int n = (lane >> 3) + 8 * j; const LAS float* s = scr + (8 * c) * 33 + n;
        v4u o; o.x = cvtpk(s[0 * 33] * sc0.x, s[1 * 33] * sc0.y); o.y = cvtpk(s[2 * 33] * sc0.z, s[3 * 33] * sc0.w); o.z = cvtpk(s[4 * 33] * sc1.x, s[5 * 33] * sc1.y); o.w = cvtpk(s[6 * 33] * sc1.z, s[7 * 33] * sc1.w);
        *(GAS v4u*)(WT + (size_t)(dst_row + n) * ldt + kdst + 8 * c) = o; }
    LDS_WAIT(); asm volatile("" ::: "memory");
}
__device__ __forceinline__ void rms_row_to_bf16(int lane, const float* xrow, const float* w, bf16* orow) {
    const GAS f32x4* xr = (const GAS f32x4*)xrow + lane;
    f32x4 v[16]; float s = 0.f;
#pragma unroll
    for (int j = 0; j < 16; ++j) { v[j] = __builtin_nontemporal_load(&xr[64 * j]); s += (v[j].x * v[j].x + v[j].y * v[j].y) + (v[j].z * v[j].z + v[j].w * v[j].w); }
    const float rstd = __builtin_amdgcn_rsqf(wave_sum(s) * (1.f / D) + EPS);
    GAS unsigned long long* o8 = (GAS unsigned long long*)orow + lane;
    const GAS f32x4* wr = (const GAS f32x4*)w + lane;
#pragma unroll
    for (int j = 0; j < 16; ++j) { const f32x4 g = wr[64 * j]; o8[64 * j] = (unsigned long long)pk2(v[j].x * rstd * g.x, v[j].y * rstd * g.y) | ((unsigned long long)pk2(v[j].z * rstd * g.z, v[j].w * rstd * g.w) << 32); }
}
__device__ __forceinline__ void rms_row_bf16_to_f32(int lane, const bf16* hrow, const float* w, float* orow) {
    const GAS v2u* hr = (const GAS v2u*)hrow + lane;
    v2u v[16]; float s = 0.f;
#pragma unroll
    for (int j = 0; j < 16; ++j) { v[j] = hr[64 * j]; const float a0 = bf_lo(v[j].x), a1 = bf_hi(v[j].x), a2 = bf_lo(v[j].y), a3 = bf_hi(v[j].y); s += (a0 * a0 + a1 * a1) + (a2 * a2 + a3 * a3); }
    const float rstd = __builtin_amdgcn_rsqf(wave_sum(s) * (1.f / D) + EPS);
    GAS f32x4* o = (GAS f32x4*)orow + lane;
    const GAS f32x4* wr = (const GAS f32x4*)w + lane;
#pragma unroll
    for (int j = 0; j < 16; ++j) { const f32x4 g = wr[64 * j]; __builtin_nontemporal_store((f32x4){bf_lo(v[j].x) * rstd * g.x, bf_hi(v[j].x) * rstd * g.y, bf_lo(v[j].y) * rstd * g.z, bf_hi(v[j].y) * rstd * g.w}, &o[64 * j]); }
}
template <int WHICH> __device__ __forceinline__ void p_convert_w(Frame& F) {
    LAS float* scr = (LAS float*)(F.lds + RING_OFF + F.wave * 16384);
    const int gw = F.vcu * NWAVES + F.wave, NGW = F.G * NWAVES;
    constexpr int I_IN = (D / 64) * (NIN / 32), I_OUT = (D / 64) * (D / 32), I_UP = (D / 64) * (NUP / 32);
    constexpr int NITEMS = WHICH == 0 ? I_IN : WHICH == 1 ? I_OUT : I_UP;
    for (int r = gw; r < NITEMS; r += NGW) {
        if constexpr (WHICH == 0) { const int nblk = NIN / 32, kb = r / nblk, nb = r % nblk; p0_transpose_item(F.w_in, NIN, F.Win_t, D, 32 * nb, 64 * kb, 32 * nb, scr, F.lane); }
        else if constexpr (WHICH == 1) { const int nblk = D / 32, kb = r / nblk, nb = r % nblk; const int k0 = 64 * kb;
            p0_transpose_item(F.w_out, D, F.Wout_t, D, 32 * nb, k0, 32 * nb, scr, F.lane, k0 >= HGW ? F.lru_norm_w - HGW : nullptr, k0 ^ HGW); }
        else { const int nblk = NUP / 32, kb = r / nblk, nb = r % nblk; int n0 = 32 * nb; const int isval = n0 >= DFF ? 1 : 0; const int c = n0 - isval * DFF;
            const int drow = 256 * (c >> 7) + 128 * isval + (c & 127);
            p0_transpose_item(F.w_up, NUP, F.Wup_t, D, drow, 64 * kb, n0, scr, F.lane, F.ln2_w); }
    }
}
__device__ __forceinline__ void p0_prologue(Frame& F) {
    const int gw = F.vcu * NWAVES + F.wave, NGW = F.G * NWAVES;
    p_convert_w<0>(F);
    for (int m = gw; m < M; m += NGW) rms_row_to_bf16(F.lane, F.x + (size_t)m * D, F.ln1_w, F.XN + (size_t)m * D);
}
__device__ __forceinline__ void p_convert_wdown(Frame& F, int rank, int nw) {
    LAS float* scr = (LAS float*)(F.lds + RING_OFF + F.wave * 16384);
    constexpr int I_DN = (DFF / 64) * (D / 32);
    for (int it = rank * NWAVES + F.wave; it < I_DN; it += nw * NWAVES) { const int nblk = D / 32, kb = it / nblk, nb = it % nblk;
        p0_transpose_item(F.w_down, D, F.Wdn_t, DFF, 32 * nb, 64 * kb, 32 * nb, scr, F.lane); }
}
struct EpiProj {
    static constexpr bool PERM = true, HAS_PRE = false;
    bf16* O; const float* lb_gamma;
    __device__ __forceinline__ void operator()(const pg8::f32x4 (&acc)[2][2][4][2], const pg8::Unit& u, int wr, int wc, int fr, int fq) const {
        const int row0 = u.pm * 256 + wr * 64 + fr, col0 = u.pn * 256 + wc * 32 + 8 * fq;
        const int grp = u.pn >> 3;
        float oml[2][8];
        if (grp == 1) {
#pragma unroll
            for (int bj = 0; bj < 2; ++bj)
#pragma unroll
                for (int j = 0; j < 8; ++j) { const int c = col0 + bj * 128 + j - HGW; oml[bj][j] = __builtin_amdgcn_rcpf(1.0f + fexp(lb_gamma[c] - lb_gamma[HGW + c])); }
        } else {
#pragma unroll
            for (int bj = 0; bj < 2; ++bj)
#pragma unroll
                for (int j = 0; j < 8; ++j) oml[bj][j] = 0.f;
        }
#pragma unroll
        for (int ai = 0; ai < 2; ++ai)
#pragma unroll
            for (int m = 0; m < 4; ++m) { bf16* rowp = O + (size_t)(row0 + ai * 128 + m * 16) * NIN + col0;
#pragma unroll
                for (int bj = 0; bj < 2; ++bj) { float v[8];
#pragma unroll
                    for (int j = 0; j < 8; ++j) v[j] = acc[ai][bj][m][j >> 2][j & 3];
                    if (grp == 0 || grp == 3) {
#pragma unroll
                        for (int j = 0; j < 8; ++j) v[j] = siluf_(v[j]);
                    } else if (grp == 1) {
#pragma unroll
                        for (int j = 0; j < 8; ++j) v[j] = oml[bj][j] * __builtin_amdgcn_rcpf(1.0f + fexp(v[j]));
                    } else if (grp == 5) {
#pragma unroll
                        for (int j = 0; j < 8; ++j) v[j] = gelu_tanh_(v[j]);
                    }
                    pg8::u32x4 w; w.x = pg8::cvt_pk_bf16(v[0], v[1]); w.y = pg8::cvt_pk_bf16(v[2], v[3]); w.z = pg8::cvt_pk_bf16(v[4], v[5]); w.w = pg8::cvt_pk_bf16(v[6], v[7]);
                    *(pg8::u32x4*)(rowp + bj * 128) = w; } }
    }
};
struct EpiRes2 {
    static constexpr bool PERM = true, HAS_PRE = false;
    const float* x; bf16* H; float* ssq;
    __device__ __forceinline__ void operator()(const pg8::f32x4 (&acc)[2][2][4][2], const pg8::Unit& u, int wr, int wc, int fr, int fq) const {
        const int row0 = u.pm * 256 + wr * 64 + fr, col0 = u.pn * 256 + wc * 32 + 8 * fq;
#pragma unroll
        for (int ai = 0; ai < 2; ++ai) {
            pg8::f32x4 r[4][2][2];
#pragma unroll
            for (int m = 0; m < 4; ++m) { const size_t off = (size_t)(row0 + ai * 128 + m * 16) * D + col0;
#pragma unroll
                for (int bj = 0; bj < 2; ++bj) { r[m][bj][0] = *(const pg8::f32x4*)(x + off + bj * 128); r[m][bj][1] = *(const pg8::f32x4*)(x + off + bj * 128 + 4); } }
#pragma unroll
            for (int m = 0; m < 4; ++m) { const int row = row0 + ai * 128 + m * 16; const size_t off = (size_t)row * D + col0; float ss = 0.f;
#pragma unroll
                for (int bj = 0; bj < 2; ++bj) { const pg8::f32x4 v0 = r[m][bj][0] + acc[ai][bj][m][0], v1 = r[m][bj][1] + acc[ai][bj][m][1];
                    ss += ((v0[0] * v0[0] + v0[1] * v0[1]) + (v0[2] * v0[2] + v0[3] * v0[3])) + ((v1[0] * v1[0] + v1[1] * v1[1]) + (v1[2] * v1[2] + v1[3] * v1[3]));
                    pg8::u32x4 w; w.x = pg8::cvt_pk_bf16(v0[0], v0[1]); w.y = pg8::cvt_pk_bf16(v0[2], v0[3]); w.z = pg8::cvt_pk_bf16(v1[0], v1[1]); w.w = pg8::cvt_pk_bf16(v1[2], v1[3]);
                    *(pg8::u32x4*)(H + off + bj * 128) = w; }
                ss += __shfl_xor(ss, 16); ss += __shfl_xor(ss, 32);
                if (fq == 0) ssq[(size_t)row * 64 + u.pn * 4 + wc] = ss; }
            asm volatile("" ::: "memory");
        }
    }
};
struct EpiRes4 {
    static constexpr bool PERM = true, HAS_PRE = false;
    bf16* H;
    __device__ __forceinline__ void operator()(const pg8::f32x4 (&acc)[2][2][4][2], const pg8::Unit& u, int wr, int wc, int fr, int fq) const {
        const int row0 = u.pm * 256 + wr * 64 + fr, col0 = u.pn * 256 + wc * 32 + 8 * fq;
#pragma unroll
        for (int ai = 0; ai < 2; ++ai) {
            pg8::u32x4 r[4][2];
#pragma unroll
            for (int m = 0; m < 4; ++m) { const size_t off = (size_t)(row0 + ai * 128 + m * 16) * D + col0;
#pragma unroll
                for (int bj = 0; bj < 2; ++bj) r[m][bj] = *(const pg8::u32x4*)(H + off + bj * 128); }
#pragma unroll
            for (int m = 0; m < 4; ++m) { const size_t off = (size_t)(row0 + ai * 128 + m * 16) * D + col0;
#pragma unroll
                for (int bj = 0; bj < 2; ++bj) { const pg8::u32x4 h = r[m][bj]; const pg8::f32x4 a0 = acc[ai][bj][m][0], a1 = acc[ai][bj][m][1];
                    pg8::u32x4 w; w.x = pg8::cvt_pk_bf16(bf_lo(h.x) + a0[0], bf_hi(h.x) + a0[1]); w.y = pg8::cvt_pk_bf16(bf_lo(h.y) + a0[2], bf_hi(h.y) + a0[3]);
                    w.z = pg8::cvt_pk_bf16(bf_lo(h.z) + a1[0], bf_hi(h.z) + a1[1]); w.w = pg8::cvt_pk_bf16(bf_lo(h.w) + a1[2], bf_hi(h.w) + a1[3]);
                    *(pg8::u32x4*)(H + off + bj * 128) = w; } }
            asm volatile("" ::: "memory");
        }
    }
};
template <int CTRL> __device__ __forceinline__ float dppf(float v) { return __builtin_bit_cast(float, __builtin_amdgcn_update_dpp(0, __builtin_bit_cast(int, v), CTRL, 0xf, 0xf, true)); }
struct EpiUp {
    static constexpr bool PERM = true, HAS_PRE = true;
    bf16* ACT; float* SIDE; const float* cw; const float* cb; const LAS float* rst; int pm0; const float* rstg; LAS unsigned char* wl;
    const float* ct;
    __device__ __forceinline__ void pre(const pg8::Unit& u, int wid, int lane) const {
        if (wid < 4) __builtin_amdgcn_global_load_lds((const unsigned*)(ct + (size_t)u.pn * 1024 + wid * 256 + lane * 4), (LAS unsigned*)(wl + u.par * 4096 + wid * 1024), 16, 0, 0);
    }
    __device__ __forceinline__ void operator()(const pg8::f32x4 (&acc)[2][2][4][2], const pg8::Unit& u, int wr, int wc, int fr, int fq) const {
        const int strip = u.pm * 2 + wr;
        const int gc0 = u.pn * 128 + wc * 32 + 8 * fq;
        float* side = SIDE + (size_t)strip * 4 * NUP;
        float rs[8];
        if ((unsigned)(u.pm - pm0) < 8u) { const pg8::f32x4 r0 = *(const LAS pg8::f32x4*)(rst + (u.pm - pm0) * 256 + wr * 128 + 8 * fr), r1 = *(const LAS pg8::f32x4*)(rst + (u.pm - pm0) * 256 + wr * 128 + 8 * fr + 4);
            rs[0] = r0[0]; rs[1] = r0[1]; rs[2] = r0[2]; rs[3] = r0[3]; rs[4] = r1[0]; rs[5] = r1[1]; rs[6] = r1[2]; rs[7] = r1[3]; }
        else {
#pragma unroll
            for (int g = 0; g < 8; ++g) rs[g] = __hip_atomic_load(rstg + u.pm * 256 + wr * 128 + 8 * fr + g, __ATOMIC_RELAXED, __HIP_MEMORY_SCOPE_AGENT); }
        pg8::f32x4 (&X)[2][2][4][2] = const_cast<pg8::f32x4 (&)[2][2][4][2]>(acc);
#pragma unroll
        for (int g = 0; g < 8; ++g)
#pragma unroll
            for (int bj = 0; bj < 2; ++bj)
#pragma unroll
                for (int n = 0; n < 2; ++n) X[g >> 2][bj][g & 3][n] = X[g >> 2][bj][g & 3][n] * rs[g];
        unsigned pk[8][4];
#pragma unroll
        for (int n = 0; n < 2; ++n) {
            const int gc = gc0 + 4 * n;
            if (fr == 0) {
                *(pg8::f32x4*)(side + gc) = X[0][0][0][n]; *(pg8::f32x4*)(side + DFF + gc) = X[0][1][0][n];
                *(pg8::f32x4*)(side + (size_t)NUP + gc) = X[0][0][1][n]; *(pg8::f32x4*)(side + (size_t)NUP + DFF + gc) = X[0][1][1][n]; }
            if (fr == 15) {
                *(pg8::f32x4*)(side + 2 * (size_t)NUP + gc) = X[1][0][2][n]; *(pg8::f32x4*)(side + 2 * (size_t)NUP + DFF + gc) = X[1][1][2][n];
                *(pg8::f32x4*)(side + 3 * (size_t)NUP + gc) = X[1][0][3][n]; *(pg8::f32x4*)(side + 3 * (size_t)NUP + DFF + gc) = X[1][1][3][n]; }
#pragma unroll
            for (int jp = 0; jp < 2; ++jp) {
                typedef float f32x2_ __attribute__((ext_vector_type(2)));
                const LAS float* wp = (const LAS float*)(wl + u.par * 4096) + wc * 32 + 8 * fq + 4 * n + 2 * jp;
                const f32x2_ wg0 = *(const LAS f32x2_*)(wp), wg1 = *(const LAS f32x2_*)(wp + 128), wg2 = *(const LAS f32x2_*)(wp + 256), bg = *(const LAS f32x2_*)(wp + 384);
                const f32x2_ wv0 = *(const LAS f32x2_*)(wp + 512), wv1 = *(const LAS f32x2_*)(wp + 640), wv2 = *(const LAS f32x2_*)(wp + 768), bv = *(const LAS f32x2_*)(wp + 896);
                float o[8][2];
#pragma unroll
                for (int jj = 0; jj < 2; ++jj) { const int j = 2 * jp + jj;
                    float Xg[8], Xv[8];
#pragma unroll
                    for (int g = 0; g < 8; ++g) { Xg[g] = X[g >> 2][0][g & 3][n][j]; Xv[g] = X[g >> 2][1][g & 3][n][j]; }
                    const float hg7 = dppf<0x111>(Xg[7]), hg6 = dppf<0x111>(Xg[6]), hv7 = dppf<0x111>(Xv[7]), hv6 = dppf<0x111>(Xv[6]);
#pragma unroll
                    for (int g = 0; g < 8; ++g) {
                        const float g1 = g >= 1 ? Xg[g >= 1 ? g - 1 : 0] : hg7, g2 = g >= 2 ? Xg[g >= 2 ? g - 2 : 0] : (g == 1 ? hg7 : hg6);
                        const float v1 = g >= 1 ? Xv[g >= 1 ? g - 1 : 0] : hv7, v2 = g >= 2 ? Xv[g >= 2 ? g - 2 : 0] : (g == 1 ? hv7 : hv6);
                        const float cg = bg[jj] + wg2[jj] * Xg[g] + wg1[jj] * g1 + wg0[jj] * g2;
                        const float cv = bv[jj] + wv2[jj] * Xv[g] + wv1[jj] * v1 + wv0[jj] * v2;
                        o[g][jj] = siluf_(cg) * cv; } }
#pragma unroll
                for (int g = 0; g < 8; ++g) pk[g][2 * n + jp] = pg8::cvt_pk_bf16(o[g][0], o[g][1]);
            }
        }
#pragma unroll
        for (int g = 0; g < 8; ++g) { pg8::u32x4 w; w.x = pk[g][0]; w.y = pk[g][1]; w.z = pk[g][2]; w.w = pk[g][3];
            *(pg8::u32x4*)(ACT + (size_t)(strip * 128 + 8 * fr + g) * DFF + gc0) = w; }
    }
};

#define LBAR() do { asm volatile("s_waitcnt lgkmcnt(0)" ::: "memory"); __builtin_amdgcn_s_barrier(); asm volatile("" ::: "memory"); } while (0)
typedef short bf16x8_t __attribute__((ext_vector_type(8)));
__device__ __forceinline__ float row16_sum(float v) {
    v += __builtin_bit_cast(float, __builtin_amdgcn_update_dpp(0, __builtin_bit_cast(int, v), 0x128, 0xf, 0xf, false));
    v += __builtin_bit_cast(float, __builtin_amdgcn_update_dpp(0, __builtin_bit_cast(int, v), 0x124, 0xf, 0xf, false));
    v += __builtin_bit_cast(float, __builtin_amdgcn_update_dpp(0, __builtin_bit_cast(int, v), 0x122, 0xf, 0xf, false));
    v += __builtin_bit_cast(float, __builtin_amdgcn_update_dpp(0, __builtin_bit_cast(int, v), 0x121, 0xf, 0xf, false));
    return v;
}
__device__ __forceinline__ void hgrn_unit(Frame& F, int b, int h) {
    constexpr int QS = 0, KS = 16384, GS = 32768, KT = 49152, VT = 67584, TS = 144, PS = 86016, OS = 95232, OSS = 528, SEGS = 129024, DEC = 133120;
    LAS unsigned char* L = F.lds;
    const int tid = F.tid, lane = F.lane, w = F.wave, quad = lane >> 4, l16 = lane & 15;
    const int vrow = 16 * w + l16;
    f32x4 Sacc[8];
#pragma unroll
    for (int kt = 0; kt < 8; ++kt) Sacc[kt] = (f32x4){0.f, 0.f, 0.f, 0.f};
    for (int i = tid; i < 9216 / 4; i += 512) ((LAS unsigned*)(L + PS))[i] = 0u;
    const int t_o = tid >> 3, part = tid & 7;
    f32x4 nw[4];
#pragma unroll
    for (int i = 0; i < 4; ++i) nw[i] = *(const GAS f32x4*)(F.hg_norm_w + h * HD + 16 * part + 4 * i);
    const bf16* src = F.PROJ + (size_t)(b * SEQ) * NIN + h * HD;
    v4u pre[2][4];
#pragma unroll
    for (int it = 0; it < 2; ++it) { const int p = tid + 512 * it, row = p >> 4, c = p & 15;
#pragma unroll
        for (int a = 0; a < 4; ++a) pre[it][a] = *(const GAS v4u*)(src + (size_t)row * NIN + a * HGW + c * 8); }
    const int cbase = (((lane >> 2) ^ (8 * (w & 1))) << 4), boff = (lane & 3) * 4;
    for (int ch = 0; ch < SEQ / 64; ++ch) {
        const int t0 = 64 * ch;
#pragma unroll
        for (int it = 0; it < 2; ++it) { const int p = tid + 512 * it, row = p >> 4, c = p & 15; const int sw = (c ^ (row & 15)) * 16;
            *(LAS v4u*)(L + QS + row * 256 + sw) = pre[it][0]; *(LAS v4u*)(L + KS + row * 256 + sw) = pre[it][1]; *(LAS v4u*)(L + GS + row * 256 + c * 16) = pre[it][3];
            const v4u vv = pre[it][2]; LAS unsigned short* vt = (LAS unsigned short*)(L + VT + (8 * c) * TS + row * 2);
            vt[0 * (TS / 2)] = (unsigned short)(vv.x & 0xffffu); vt[1 * (TS / 2)] = (unsigned short)(vv.x >> 16); vt[2 * (TS / 2)] = (unsigned short)(vv.y & 0xffffu); vt[3 * (TS / 2)] = (unsigned short)(vv.y >> 16);
            vt[4 * (TS / 2)] = (unsigned short)(vv.z & 0xffffu); vt[5 * (TS / 2)] = (unsigned short)(vv.z >> 16); vt[6 * (TS / 2)] = (unsigned short)(vv.w & 0xffffu); vt[7 * (TS / 2)] = (unsigned short)(vv.w >> 16); }
        LBAR();
        if (ch + 1 < SEQ / 64) {
#pragma unroll
            for (int it = 0; it < 2; ++it) { const int p = tid + 512 * it, row = p >> 4, c = p & 15;
#pragma unroll
                for (int a = 0; a < 4; ++a) pre[it][a] = *(const GAS v4u*)(src + (size_t)(t0 + 64 + row) * NIN + a * HGW + c * 8); } }
        { float k0[8], k1[8], P0[8], P1[8]; float r0 = 1.f, r1 = 1.f;
#pragma unroll
          for (int i = 0; i < 8; ++i) { const unsigned kk = *(const LAS unsigned*)(L + KS + (8 * w + i) * 256 + (cbase ^ (i << 4)) + boff);
              k0[i] = bf_lo(kk); k1[i] = bf_hi(kk); r0 *= (1.0f - k0[i]); r1 *= (1.0f - k1[i]); P0[i] = r0; P1[i] = r1; }
          *(LAS f32x2*)(L + SEGS + (w * 128 + 2 * lane) * 4) = (f32x2){r0, r1};
          LBAR();
          float b0 = 1.f, b1 = 1.f, tt0 = 1.f, tt1 = 1.f;
#pragma unroll
          for (int w2 = 0; w2 < 8; ++w2) { const f32x2 sg = *(const LAS f32x2*)(L + SEGS + (w2 * 128 + 2 * lane) * 4); tt0 *= sg.x; tt1 *= sg.y; if (w2 < w) { b0 *= sg.x; b1 *= sg.y; } }
          unsigned kh0[4], kh1[4];
#pragma unroll
          for (int i = 0; i < 8; i += 2) { float hv0[2], hv1[2];
#pragma unroll
              for (int u = 0; u < 2; ++u) { const int ii = i + u; const int ad = (8 * w + ii) * 256 + (cbase ^ (ii << 4)) + boff;
                  const float e0 = b0 * P0[ii], e1 = b1 * P1[ii];
                  const float i0 = __builtin_amdgcn_rcpf(fmaxf(e0, 1e-35f)), i1 = __builtin_amdgcn_rcpf(fmaxf(e1, 1e-35f));
                  const unsigned qq = *(const LAS unsigned*)(L + QS + ad);
                  *(LAS unsigned*)(L + QS + ad) = cvtpk(bf_lo(qq) * e0, bf_hi(qq) * e1);
                  const float kt0 = k0[ii] * i0, kt1 = k1[ii] * i1;
                  *(LAS unsigned*)(L + KS + ad) = cvtpk(kt0, kt1);
                  hv0[u] = kt0 * tt0; hv1[u] = kt1 * tt1; }
              kh0[i >> 1] = cvtpk(hv0[0], hv0[1]); kh1[i >> 1] = cvtpk(hv1[0], hv1[1]); }
          *(LAS v4u*)(L + KT + (2 * lane) * TS + 16 * w) = (v4u){kh0[0], kh0[1], kh0[2], kh0[3]};
          *(LAS v4u*)(L + KT + (2 * lane + 1) * TS + 16 * w) = (v4u){kh1[0], kh1[1], kh1[2], kh1[3]};
          if (w == 0) *(LAS f32x2*)(L + DEC + (2 * lane) * 4) = (f32x2){tt0, tt1}; }
        LBAR();
#pragma unroll
        for (int rep = 0; rep < 2; ++rep) { const int idx = w + 8 * rep;
            if (idx < 10) { const int ti = (idx >= 6) ? 3 : (idx >= 3) ? 2 : (idx >= 1) ? 1 : 0, si = idx - ((ti * (ti + 1)) >> 1);
                f32x4 acc = (f32x4){0.f, 0.f, 0.f, 0.f};
#pragma unroll
                for (int ks = 0; ks < 4; ++ks) { const int rk = 16 * si + l16, rq = 16 * ti + l16;
                    const bf16x8_t Ak = *(const LAS bf16x8_t*)(L + KS + rk * 256 + (((4 * ks + quad) ^ (rk & 15)) * 16));
                    const bf16x8_t Bq = *(const LAS bf16x8_t*)(L + QS + rq * 256 + (((4 * ks + quad) ^ (rq & 15)) * 16));
                    acc = __builtin_amdgcn_mfma_f32_16x16x32_bf16(Ak, Bq, acc, 0, 0, 0); }
                if (si == ti) {
#pragma unroll
                    for (int j = 0; j < 4; ++j) acc[j] = (4 * quad + j > l16) ? 0.f : acc[j]; }
                *(LAS v2u*)(L + PS + (16 * ti + l16) * TS + (16 * si + 4 * quad) * 2) = (v2u){cvtpk(acc[0], acc[1]), cvtpk(acc[2], acc[3])}; } }
        f32x4 O[4];
        { unsigned Sb[8][2];
#pragma unroll
          for (int kt = 0; kt < 8; ++kt) { Sb[kt][0] = cvtpk(Sacc[kt][0], Sacc[kt][1]); Sb[kt][1] = cvtpk(Sacc[kt][2], Sacc[kt][3]); }
#pragma unroll
          for (int ti = 0; ti < 4; ++ti) { O[ti] = (f32x4){0.f, 0.f, 0.f, 0.f};
#pragma unroll
              for (int ks = 0; ks < 4; ++ks) { const int rq = 16 * ti + l16;
                  const bf16x8_t Aq = *(const LAS bf16x8_t*)(L + QS + rq * 256 + (((4 * ks + quad) ^ (rq & 15)) * 16));
                  const v4u Bu = (v4u){Sb[2 * ks][0], Sb[2 * ks][1], Sb[2 * ks + 1][0], Sb[2 * ks + 1][1]};
                  O[ti] = __builtin_amdgcn_mfma_f32_16x16x32_bf16(Aq, __builtin_bit_cast(bf16x8_t, Bu), O[ti], 0, 0, 0); } } }
        const v4u g0 = *(const LAS v4u*)(L + GS + t_o * 256 + part * 32), g1 = *(const LAS v4u*)(L + GS + t_o * 256 + part * 32 + 16);
        LBAR();
        { bf16x8_t Bv[2];
#pragma unroll
          for (int p = 0; p < 2; ++p) Bv[p] = *(const LAS bf16x8_t*)(L + VT + vrow * TS + (32 * p + 8 * quad) * 2);
#pragma unroll
          for (int ti = 0; ti < 4; ++ti)
#pragma unroll
              for (int p = 0; p < 2; ++p) if (2 * p <= ti) { const bf16x8_t Ap = *(const LAS bf16x8_t*)(L + PS + (16 * ti + l16) * TS + (32 * p + 8 * quad) * 2);
                  O[ti] = __builtin_amdgcn_mfma_f32_16x16x32_bf16(Ap, Bv[p], O[ti], 0, 0, 0); }
#pragma unroll
          for (int kt = 0; kt < 8; ++kt) { const int kb = 32 * (kt >> 1) + 4 * (kt & 1);
              const f32x4 d4 = *(const LAS f32x4*)(L + DEC + (kb + 8 * quad) * 4); Sacc[kt] = Sacc[kt] * d4;
              const int kdr = kb + 8 * (l16 >> 2) + (l16 & 3);
#pragma unroll
              for (int ks = 0; ks < 2; ++ks) { const bf16x8_t Ak = *(const LAS bf16x8_t*)(L + KT + kdr * TS + (32 * ks + 8 * quad) * 2);
                  Sacc[kt] = __builtin_amdgcn_mfma_f32_16x16x32_bf16(Ak, Bv[ks], Sacc[kt], 0, 0, 0); } } }
#pragma unroll
        for (int ti = 0; ti < 4; ++ti)
#pragma unroll
            for (int j = 0; j < 4; ++j) *(LAS float*)(L + OS + (16 * ti + 4 * quad + j) * OSS + vrow * 4) = O[ti][j];
        LBAR();
        { const LAS f32x4* op = (const LAS f32x4*)(L + OS + t_o * OSS + part * 64);
          const f32x4 o0 = op[0], o1 = op[1], o2 = op[2], o3 = op[3];
          float ss = ((o0.x * o0.x + o0.y * o0.y) + (o0.z * o0.z + o0.w * o0.w)) + ((o1.x * o1.x + o1.y * o1.y) + (o1.z * o1.z + o1.w * o1.w))
                   + ((o2.x * o2.x + o2.y * o2.y) + (o2.z * o2.z + o2.w * o2.w)) + ((o3.x * o3.x + o3.y * o3.y) + (o3.z * o3.z + o3.w * o3.w));
          ss += __shfl_xor(ss, 1); ss += __shfl_xor(ss, 2); ss += __shfl_xor(ss, 4);
          const float rstd = __builtin_amdgcn_rsqf(ss * (1.0f / HD) + EPS);
          const f32x4 r0 = o0 * rstd * nw[0] * (f32x4){bf_lo(g0.x), bf_hi(g0.x), bf_lo(g0.y), bf_hi(g0.y)}, r1 = o1 * rstd * nw[1] * (f32x4){bf_lo(g0.z), bf_hi(g0.z), bf_lo(g0.w), bf_hi(g0.w)};
          const f32x4 r2 = o2 * rstd * nw[2] * (f32x4){bf_lo(g1.x), bf_hi(g1.x), bf_lo(g1.y), bf_hi(g1.y)}, r3 = o3 * rstd * nw[3] * (f32x4){bf_lo(g1.z), bf_hi(g1.z), bf_lo(g1.w), bf_hi(g1.w)};
          GAS v4u* dst = (GAS v4u*)(F.MIX + (size_t)(b * SEQ + t0 + t_o) * D + LRUW + h * HD + 16 * part);
          dst[0] = (v4u){cvtpk(r0.x, r0.y), cvtpk(r0.z, r0.w), cvtpk(r1.x, r1.y), cvtpk(r1.z, r1.w)}; dst[1] = (v4u){cvtpk(r2.x, r2.y), cvtpk(r2.z, r2.w), cvtpk(r3.x, r3.y), cvtpk(r3.z, r3.w)}; }
    }
    __syncthreads();
}

__device__ __forceinline__ void lru_unit(Frame& F, int b, int blk) {
    constexpr int XR = 0, XF = 17408, XH = 50176, XHS = 272, AS = 67584, US = 100352, SGA = 133120, SGU = SGA + 2048, HST = SGU + 2048;
    LAS unsigned char* L = F.lds;
    const int tid = F.tid, lane = F.lane, w = F.wave, quad = lane >> 4, l16 = lane & 15;
    const int e_own = tid & 127, seg = tid >> 7, chc = blk * LBD + e_own;
    const int em = 16 * w + l16, chm = blk * LBD + em;
    const float cw0 = F.lru_conv_w[chc], cw1 = F.lru_conv_w[LRUW + chc], cw2 = F.lru_conv_w[2 * LRUW + chc], cw3 = F.lru_conv_w[3 * LRUW + chc], cbv = F.lru_conv_b[chc];
    const float nba = -1.44269504089f * F.lru_ba[chm], nbx = -1.44269504089f * F.lru_bx[chm];
    const float lam = F.lru_lambda[chm];
    const float c2 = 16.0f * (fmaxf(-lam, 0.f) + log1pf(expf(-fabsf(lam))));
    bf16x8_t Bwa[4], Bwx[4];
#pragma unroll
    for (int ks = 0; ks < 4; ++ks)
#pragma unroll
        for (int i = 0; i < 8; ++i) { const int d = 32 * ks + 8 * quad + i;
            Bwa[ks][i] = (short)f2bf(F.lru_wa[((size_t)blk * LBD + d) * LBD + em]); Bwx[ks][i] = (short)f2bf(F.lru_wx[((size_t)blk * LBD + d) * LBD + em]); }
    if (tid < 256) ((LAS float*)(L + HST))[tid] = 0.f;
    const bf16* xsrc = F.PROJ + (size_t)(b * SEQ) * NIN + 4 * HGW + blk * LBD;
    const bf16* ysrc = xsrc + LRUW;
    v4u px[3]; unsigned short py[16];
#pragma unroll
    for (int it = 0; it < 3; ++it) { const int p = tid + 512 * it; px[it] = (v4u){0u, 0u, 0u, 0u}; if (p < 67 * 16) { const int row = p >> 4, s16 = p & 15, t = row - 3; if (t >= 0) px[it] = *(const GAS v4u*)(xsrc + (size_t)t * NIN + s16 * 8); } }
#pragma unroll
    for (int i = 0; i < 16; ++i) py[i] = *(const GAS unsigned short*)(ysrc + (size_t)(16 * seg + i) * NIN + e_own);
    for (int c = 0; c < SEQ / 64; ++c) {
        const int t0 = 64 * c;
#pragma unroll
        for (int it = 0; it < 3; ++it) { const int p = tid + 512 * it; if (p < 67 * 16) { const int row = p >> 4, s16 = p & 15; *(LAS v4u*)(L + XR + row * 256 + s16 * 16) = px[it]; } }
        LBAR();
        if (c + 1 < SEQ / 64) {
#pragma unroll
            for (int it = 0; it < 3; ++it) { const int p = tid + 512 * it; if (p < 67 * 16) { const int row = p >> 4, s16 = p & 15; px[it] = *(const GAS v4u*)(xsrc + (size_t)(t0 + 61 + row) * NIN + s16 * 8); } }
        }
        { const LAS unsigned short* xr = (const LAS unsigned short*)(L + XR) + e_own;
          float x0 = __builtin_bit_cast(float, (unsigned)xr[(16 * seg + 0) * 128] << 16), x1 = __builtin_bit_cast(float, (unsigned)xr[(16 * seg + 1) * 128] << 16), x2 = __builtin_bit_cast(float, (unsigned)xr[(16 * seg + 2) * 128] << 16);
#pragma unroll
          for (int i = 0; i < 16; ++i) { const int t = 16 * seg + i; const float x3 = __builtin_bit_cast(float, (unsigned)xr[(t + 3) * 128] << 16);
              const float xb = cbv + cw0 * x0 + cw1 * x1 + cw2 * x2 + cw3 * x3;
              ((LAS float*)(L + XF))[t * 128 + e_own] = xb; *(LAS unsigned short*)(L + XH + t * XHS + e_own * 2) = (unsigned short)cvtpk(xb, xb);
              x0 = x1; x1 = x2; x2 = x3; } }
        LBAR();
#pragma unroll 1
        for (int mt = 0; mt < 4; ++mt) {
            f32x4 R = (f32x4){0.f, 0.f, 0.f, 0.f}, I = R;
#pragma unroll
            for (int ks = 0; ks < 4; ++ks) { const bf16x8_t A = *(const LAS bf16x8_t*)(L + XH + (16 * mt + l16) * XHS + (32 * ks + 8 * quad) * 2);
                R = __builtin_amdgcn_mfma_f32_16x16x32_bf16(A, Bwa[ks], R, 0, 0, 0); I = __builtin_amdgcn_mfma_f32_16x16x32_bf16(A, Bwx[ks], I, 0, 0, 0); }
            f32x4 e1, e2;
#pragma unroll
            for (int j = 0; j < 4; ++j) { e1[j] = __builtin_amdgcn_exp2f(R[j] * -1.44269504089f + nba); e2[j] = __builtin_amdgcn_exp2f(I[j] * -1.44269504089f + nbx); }
            const f32x4 d1 = e1 + 1.0f, d2 = e2 + 1.0f, dd = d1 * d2;
            f32x4 inv;
#pragma unroll
            for (int j = 0; j < 4; ++j) inv[j] = __builtin_amdgcn_rcpf(dd[j]);
            const f32x4 r = inv * d2, ig = inv * d1, z = r * c2;
            f32x4 av = 1.0f + z * (-0.5f + z * (0.125f + z * ((-1.0f / 48.0f) + z * ((1.0f / 384.0f) + z * (-1.0f / 3840.0f)))));
            f32x4 om = z * (1.0f + z * (-0.5f + z * ((1.0f / 6.0f) + z * ((-1.0f / 24.0f) + z * ((1.0f / 120.0f) + z * (-1.0f / 720.0f))))));
            const bool big = (z[0] > 0.35f) | (z[1] > 0.35f) | (z[2] > 0.35f) | (z[3] > 0.35f);
            if (__builtin_amdgcn_ballot_w64(big) != 0ull) {
#pragma unroll
                for (int j = 0; j < 4; ++j) if (z[j] > 0.35f) { av[j] = fexp(-0.5f * z[j]); om[j] = 1.0f - av[j] * av[j]; } }
            f32x4 mult;
#pragma unroll
            for (int j = 0; j < 4; ++j) mult[j] = __builtin_amdgcn_sqrtf(om[j]);
            if (c == 0 && mt == 0 && quad == 0) mult[0] = 1.0f;
            const LAS float* xf = (const LAS float*)(L + XF) + (16 * mt + 4 * quad) * 128 + em;
            const f32x4 xbv = (f32x4){xf[0], xf[128], xf[256], xf[384]};
            const f32x4 uv = xbv * ig * mult;
            LAS float* ap = (LAS float*)(L + AS) + (16 * mt + 4 * quad) * 128 + em; LAS float* up = (LAS float*)(L + US) + (16 * mt + 4 * quad) * 128 + em;
#pragma unroll
            for (int j = 0; j < 4; ++j) { ap[j * 128] = av[j]; up[j * 128] = uv[j]; } }
        LBAR();
        { const LAS float* as = (const LAS float*)(L + AS) + e_own; const LAS float* us = (const LAS float*)(L + US) + e_own;
          float Aacc = 1.0f, Uacc = 0.0f;
#pragma unroll
          for (int i = 0; i < 16; ++i) { const int t = 16 * seg + i; const float a = as[t * 128], u = us[t * 128]; Uacc = a * Uacc + u; Aacc *= a; }
          ((LAS float*)(L + SGA))[seg * 128 + e_own] = Aacc; ((LAS float*)(L + SGU))[seg * 128 + e_own] = Uacc;
          LBAR();
          float h = ((LAS float*)(L + HST))[(c & 1) * 128 + e_own];
#pragma unroll
          for (int s2 = 0; s2 < 3; ++s2) if (s2 < seg) h = ((LAS float*)(L + SGA))[s2 * 128 + e_own] * h + ((LAS float*)(L + SGU))[s2 * 128 + e_own];
#pragma unroll
          for (int i = 0; i < 16; ++i) { const int t = 16 * seg + i; const float a = as[t * 128], u = us[t * 128]; h = a * h + u;
              ((LAS float*)(L + AS))[t * 128 + e_own] = h * __builtin_bit_cast(float, (unsigned)py[i] << 16); }
          if (seg == 3) ((LAS float*)(L + HST))[((c + 1) & 1) * 128 + e_own] = h;
          if (c + 1 < SEQ / 64) {
#pragma unroll
              for (int i = 0; i < 16; ++i) py[i] = *(const GAS unsigned short*)(ysrc + (size_t)(t0 + 64 + 16 * seg + i) * NIN + e_own); } }
        LBAR();
        { const int t = tid >> 3, part = tid & 7; const LAS f32x4* o4 = (const LAS f32x4*)(L + AS + (t * 128 + 16 * part) * 4);
          const f32x4 o0 = o4[0], o1 = o4[1], o2 = o4[2], o3 = o4[3];
          float ss = ((o0.x * o0.x + o0.y * o0.y) + (o0.z * o0.z + o0.w * o0.w)) + ((o1.x * o1.x + o1.y * o1.y) + (o1.z * o1.z + o1.w * o1.w))
                   + ((o2.x * o2.x + o2.y * o2.y) + (o2.z * o2.z + o2.w * o2.w)) + ((o3.x * o3.x + o3.y * o3.y) + (o3.z * o3.z + o3.w * o3.w));
          ss += __shfl_xor(ss, 1); ss += __shfl_xor(ss, 2); ss += __shfl_xor(ss, 4);
          const size_t row = (size_t)(b * SEQ + t0 + t);
          v4u p0, p1; p0.x = cvtpk(o0.x, o0.y); p0.y = cvtpk(o0.z, o0.w); p0.z = cvtpk(o1.x, o1.y); p0.w = cvtpk(o1.z, o1.w); p1.x = cvtpk(o2.x, o2.y); p1.y = cvtpk(o2.z, o2.w); p1.z = cvtpk(o3.x, o3.y); p1.w = cvtpk(o3.z, o3.w);
          GAS v4u* dst = (GAS v4u*)(F.MIX + row * D + blk * LBD + 16 * part); dst[0] = p0; dst[1] = p1;
          if (part == 0) F.SSQL[(size_t)blk * M + row] = ss; }
    }
    __syncthreads();
}

constexpr int N_PHASES = 10;
struct Args { const float* in[20]; float* out; unsigned char* ws; int ph_lo, ph_hi; };
__global__ void __launch_bounds__(NWAVES * 64, 2) fwd_kernel(Args args) {
    extern __shared__ __attribute__((aligned(16))) unsigned char lds[];
    Frame F;
    F.lds = (LAS unsigned char*)lds;
    F.MISC = (volatile LAS unsigned*)(F.lds + MISC_OFF);
    F.tid = threadIdx.x; F.lane = F.tid & 63; F.wave = __builtin_amdgcn_readfirstlane(F.tid >> 6);
    F.G = gridDim.x; { const int bx = blockIdx.x; F.vcu = (F.G % 8 == 0) ? (bx % 8) * (F.G / 8) + bx / 8 : bx; }
    unsigned char* ws = args.ws;
    F.ctl = (gu32*)(ws + WS_CTL);
    F.x = args.in[0]; F.ln1_w = args.in[1]; F.w_in = args.in[2]; F.lb_gamma = args.in[3]; F.hg_norm_w = args.in[4]; F.lru_conv_w = args.in[5]; F.lru_conv_b = args.in[6];
    F.lru_wa = args.in[7]; F.lru_ba = args.in[8]; F.lru_wx = args.in[9]; F.lru_bx = args.in[10]; F.lru_lambda = args.in[11]; F.lru_norm_w = args.in[12]; F.w_out = args.in[13];
    F.ln2_w = args.in[14]; F.w_up = args.in[15]; F.ffn_conv_w = args.in[16]; F.ffn_conv_b = args.in[17]; F.w_down = args.in[18]; F.final_norm_w = args.in[19]; F.out = args.out;
    F.Win_t = (bf16*)(ws + WS_WIN); F.Wout_t = (bf16*)(ws + WS_WOUT); F.Wup_t = (bf16*)(ws + WS_WUP); F.Wdn_t = (bf16*)(ws + WS_WDN);
    F.XN = (bf16*)(ws + WS_XN); F.PROJ = (bf16*)(ws + WS_PROJ); F.MIX = (bf16*)(ws + WS_MIX); F.ACT = (bf16*)(ws + WS_ACT);
    F.SIDE = (float*)(ws + WS_SIDE); F.SSQL = (float*)(ws + WS_SSQL); F.SSQ2 = (float*)(ws + WS_SSQ2); F.RSTG = (float*)(ws + WS_RSTG); F.CT = (float*)(ws + WS_CT);
    for (int u = F.tid; u < (WL_OFF - LDSCTL_OFF) / 4; u += NWAVES * 64) ((LAS unsigned*)(F.lds + LDSCTL_OFF))[u] = 0u;
    __syncthreads();
    XcdBarrier bar; bar.bar = (unsigned*)(F.ctl + CW_BAR); bar.x = 0; bar.st = nullptr;
    if (MK_N_LAUNCHES == 1) bar = xcd_barrier_post((unsigned*)(F.ctl + CW_BAR), F.MISC + 8);
    const int lo = args.ph_lo, hi = args.ph_hi;
#define IN(k) (lo <= (k) && (k) < hi)
#define SEAM(k) do { if (IN(k) && IN((k) + 1)) xcd_barrier(bar); } while (0)
    const int gw = F.vcu * NWAVES + F.wave, NGW = F.G * NWAVES;

    if (IN(0)) { p0_prologue(F);
        for (int i = F.vcu * 512 + F.tid; i < (NUP / 256) * 1024; i += F.G * 512) { const int pn = i >> 10, a = (i >> 7) & 7, c = i & 127;
            const int col = (a >> 2) * DFF + pn * 128 + c; F.CT[i] = (a & 3) == 3 ? F.ffn_conv_b[col] : F.ffn_conv_w[(size_t)(a & 3) * NUP + col]; } } SEAM(0);
    if (IN(1)) { pg8::Gemm g{F.XN, F.Win_t, M, NIN, D}; pg8::StaticOrder S; S.init(M, NIN, F.G, (int)blockIdx.x);
        EpiProj E{F.PROJ, F.lb_gamma};
        pg8::gemm_phase<EpiProj, pg8::StaticOrder, PG8_ALIGN, PG8_SP2, false>(F.lds + RING_OFF, g, S, E); } SEAM(1);
    if (IN(2)) { const int half = F.G >> 1;
        if (F.vcu < half) { for (int u = F.vcu; u < 128; u += half) hgrn_unit(F, u >> 4, u & 15); }
        else { for (int u = F.vcu - half; u < 128; u += half) lru_unit(F, u >> 4, u & 15); }
        p_convert_w<1>(F); }
    if (IN(2) && IN(4)) xcd_barrier(bar);
    if (IN(4)) { LAS float* RSTL = (LAS float*)(F.lds + RING_BYTES); const int x8 = (int)(blockIdx.x & 7);
        for (int r = F.tid; r < 2048; r += NWAVES * 64) { const size_t row = (size_t)2048 * x8 + r; float sacc = 0.f;
#pragma unroll
            for (int q = 0; q < 16; ++q) sacc += F.SSQL[(size_t)q * M + row];
            RSTL[r] = __builtin_amdgcn_rsqf(sacc * (1.0f / LRUW) + EPS); }
        __syncthreads();
        pg8::Gemm g{F.MIX, F.Wout_t, M, D, D}; pg8::StaticOrder S; S.init(M, D, F.G, (int)blockIdx.x);
        EpiRes2 E{F.x, F.XN, F.SSQ2};
        pg8::gemm_phase<EpiRes2, pg8::StaticOrder, PG8_ALIGN, PG8_SP2, false, true>(F.lds + RING_OFF, g, S, E, RSTL, 8 * x8);
        p_convert_w<2>(F); }
    if (IN(4) && IN(6)) xcd_barrier(bar);
    if (IN(6)) { LAS float* RST = (LAS float*)(F.lds + RING_BYTES); const int x8 = (int)(blockIdx.x & 7);
        for (int r = F.tid; r < 2048; r += NWAVES * 64) { const GAS f32x4* p = (const GAS f32x4*)(F.SSQ2 + (size_t)(2048 * x8 + r) * 64); float sacc = 0.f;
#pragma unroll
            for (int q = 0; q < 16; ++q) { const f32x4 v = p[q]; sacc += (v.x + v.y) + (v.z + v.w); }
            const float rv = __builtin_amdgcn_rsqf(sacc * (1.0f / D) + EPS); RST[r] = rv;
            if (F.G != 256 || (r >> 6) == (int)(blockIdx.x >> 3)) __hip_atomic_store(F.RSTG + (size_t)2048 * x8 + r, rv, RLX_AGENT); }
        __syncthreads();
        pg8::Gemm g{F.XN, F.Wup_t, M, NUP, D}; pg8::DynTailOrder S; S.init2(M, NUP, F.G, (int)blockIdx.x, (unsigned*)(F.ctl + 32), (volatile LAS unsigned*)(F.MISC + 24));
        EpiUp E{F.ACT, F.SIDE, F.ffn_conv_w, F.ffn_conv_b, RST, 8 * x8, F.RSTG, F.lds + WL_OFF, F.CT};
        pg8::gemm_phase<EpiUp, pg8::DynTailOrder, PG8_ALIGN, PG8_SP2, 2>(F.lds + RING_OFF, g, S, E);
        p_convert_wdown(F, F.vcu, F.G); }
    SEAM(6);
    if (IN(7)) { const size_t total = (size_t)NSTRIP * DFF;
        for (size_t i = (size_t)F.vcu * 512 + F.tid; i < total; i += (size_t)F.G * 512) { const int s = (int)(i / DFF), c = (int)(i % DFF);
            if ((s & 15) == 0) continue;
            const float* sp = F.SIDE + (size_t)(s - 1) * 4 * NUP; const float* sc = F.SIDE + (size_t)s * 4 * NUP;
            const float gm2 = sp[2 * (size_t)NUP + c], gm1 = sp[3 * (size_t)NUP + c], g0 = sc[c], g1 = sc[(size_t)NUP + c];
            const float vm2 = sp[2 * (size_t)NUP + DFF + c], vm1 = sp[3 * (size_t)NUP + DFF + c], v0 = sc[DFF + c], v1 = sc[(size_t)NUP + DFF + c];
            const float wg0 = F.ffn_conv_w[c], wg1 = F.ffn_conv_w[NUP + c], wg2 = F.ffn_conv_w[2 * NUP + c], bg = F.ffn_conv_b[c];
            const float wv0 = F.ffn_conv_w[DFF + c], wv1 = F.ffn_conv_w[NUP + DFF + c], wv2 = F.ffn_conv_w[2 * NUP + DFF + c], bv = F.ffn_conv_b[DFF + c];
            const float cg0 = bg + wg2 * g0 + wg1 * gm1 + wg0 * gm2, cv0 = bv + wv2 * v0 + wv1 * vm1 + wv0 * vm2;
            const float cg1 = bg + wg2 * g1 + wg1 * g0 + wg0 * gm1, cv1 = bv + wv2 * v1 + wv1 * v0 + wv0 * vm1;
            F.ACT[(size_t)(s * 128) * DFF + c] = (bf16)f2bf(siluf_(cg0) * cv0); F.ACT[(size_t)(s * 128 + 1) * DFF + c] = (bf16)f2bf(siluf_(cg1) * cv1); } } SEAM(7);
    if (IN(8)) { pg8::Gemm g{F.ACT, F.Wdn_t, M, D, DFF}; pg8::StaticOrder S; S.init(M, D, F.G, (int)blockIdx.x);
        EpiRes4 E{F.XN};
        pg8::gemm_phase<EpiRes4, pg8::StaticOrder, PG8_ALIGN, PG8_SP2, false>(F.lds + RING_OFF, g, S, E); } SEAM(8);
    if (IN(9)) { for (int m = gw; m < M; m += NGW) rms_row_bf16_to_f32(F.lane, F.XN + (size_t)m * D, F.final_norm_w, F.out + (size_t)m * D); }
#undef IN
#undef SEAM
}

extern "C" void kernel_launch(void* const* d_in, const int* in_sizes, int n_in, void* d_out, int out_size, void* d_ws, size_t ws_size, hipStream_t stream) {
    static int grid = 0;
    if (grid == 0) {
        if (n_in != 20 || in_sizes[0] != M * D || out_size != M * D || ws_size < WS_END) { fprintf(stderr, "kernel_launch: unexpected shapes (n_in %d, in0 %d, out %d, ws %zu < %zu); nothing launched\n", n_in, n_in > 0 ? in_sizes[0] : -1, out_size, ws_size, (size_t)WS_END); grid = -1; return; }
        int dev = 0, cus = 0, per_cu = 0;
        if (hipGetDevice(&dev) != hipSuccess || hipDeviceGetAttribute(&cus, hipDeviceAttributeMultiprocessorCount, dev) != hipSuccess) { grid = -1; return; }
        if (hipFuncSetAttribute((const void*)fwd_kernel, hipFuncAttributeMaxDynamicSharedMemorySize, LDS_BYTES) != hipSuccess) { fprintf(stderr, "kernel_launch: hipFuncSetAttribute failed\n"); grid = -1; return; }
        if (hipOccupancyMaxActiveBlocksPerMultiprocessor(&per_cu, (const void*)fwd_kernel, NWAVES * 64, LDS_BYTES) != hipSuccess || per_cu < 1)
            fprintf(stderr, "kernel_launch: note: occupancy query reports %d workgroups per CU\n", per_cu);
        (void)hipGetLastError();
        grid = cus;
    }
    if (grid < 0) return;
    if (hipMemsetAsync((char*)d_ws + WS_CTL, 0, CTL_ZERO_BYTES, stream) != hipSuccess) return;
    Args a{};
    for (int i = 0; i < 20; ++i) a.in[i] = (const float*)d_in[i];
    a.out = (float*)d_out; a.ws = (unsigned char*)d_ws;
    if (MK_N_LAUNCHES == 1) { a.ph_lo = 0; a.ph_hi = N_PHASES; hipLaunchKernelGGL(fwd_kernel, dim3(grid), dim3(NWAVES * 64), LDS_BYTES, stream, a); }
    else for (int p = 0; p < N_PHASES; ++p) { a.ph_lo = p; a.ph_hi = p + 1; hipLaunchKernelGGL(fwd_kernel, dim3(grid), dim3(NWAVES * 64), LDS_BYTES, stream, a); }
}
```
